# Optimizing an MI355X kernel written in HIP

```python
import jax, jax.numpy as jnp
from jax import lax
import numpy as np

D_MODEL = 1024
BATCH = 4
SEQ = 8192
DEPTH = 2
DEC_BATCH = 32
DEC_SEQ = 64
PAST_LEN = 4096

CHUNK = 64
HEAD_DIM = 64
N_Q_A = 8
N_KV_A = 2
WINDOW = 128
N_PAST_A = WINDOW // CHUNK
N_HEADS_B = 8
N_PAST_B = 8
REL_CLIP = 128
ROT_DIM = HEAD_DIM // 4
ROPE_THETA = 500000.0
D_FF = 2816
NORM_EPS = 1e-5
MASK_VALUE = -1e30
Q_A_W = N_Q_A * HEAD_DIM
KV_A_W = N_KV_A * HEAD_DIM
Q_B_W = N_HEADS_B * HEAD_DIM
D_IN = Q_A_W + 2 * KV_A_W + 3 * Q_B_W + 2 * D_MODEL

kernel_name = 'streaming_hybrid_swa_chunkband'


def rms_norm(x, g):
    xf = x.astype(jnp.float32)
    r = lax.rsqrt(jnp.mean(xf * xf, axis=-1, keepdims=True) + NORM_EPS)
    return (xf * r).astype(x.dtype) * g


def swiglu(h, w_in, w_out):
    z = jnp.einsum('btd,df->btf', h, w_in)
    a, b = jnp.split(z, 2, axis=-1)
    return jnp.einsum('btf,fd->btd', jax.nn.silu(a) * b, w_out)


def apply_rope(x, pos):
    half = ROT_DIM // 2
    freqs = ROPE_THETA ** (-jnp.arange(0, ROT_DIM, 2, dtype=jnp.float32) / ROT_DIM)
    ang = pos.astype(jnp.float32)[:, None] * freqs[None, :]
    cos = jnp.cos(ang)[None, :, None, :]
    sin = jnp.sin(ang)[None, :, None, :]
    xf = x.astype(jnp.float32)
    x1, x2, rest = xf[..., :half], xf[..., half:ROT_DIM], xf[..., ROT_DIM:]
    out = jnp.concatenate([x1 * cos - x2 * sin, x2 * cos + x1 * sin, rest], axis=-1)
    return out.astype(x.dtype)


def project(h, w_in, b_gate, pos):
    nb, t, _ = h.shape
    z = jnp.einsum('btd,de->bte', h, w_in)
    idx = [int(v) for v in np.cumsum([Q_A_W, KV_A_W, KV_A_W, Q_B_W, Q_B_W, Q_B_W, D_MODEL])]
    qa, ka, va, qb, kb, vb, g_a, g_b = jnp.split(z, idx, axis=-1)
    qa = apply_rope(qa.reshape(nb, t, N_Q_A, HEAD_DIM), pos)
    ka = apply_rope(ka.reshape(nb, t, N_KV_A, HEAD_DIM), pos)
    va = va.reshape(nb, t, N_KV_A, HEAD_DIM)
    qb = qb.reshape(nb, t, N_HEADS_B, HEAD_DIM)
    kb = kb.reshape(nb, t, N_HEADS_B, HEAD_DIM)
    vb = vb.reshape(nb, t, N_HEADS_B, HEAD_DIM)
    gates = jax.nn.sigmoid(jnp.concatenate([g_a, g_b], axis=-1) + b_gate)
    gate_a, gate_b = jnp.split(gates, 2, axis=-1)
    return qa, ka, va, qb, kb, vb, gate_a, gate_b


def attend(q, k, v, qpos, kpos, kvalid, sink, rel_table):
    nb, tq, hq, hd = q.shape
    tk, hkv = k.shape[1], k.shape[2]
    g = hq // hkv
    qg = q.reshape(nb, tq, hkv, g, hd)
    s = jnp.einsum('bqhgd,bkhd->bhgqk', qg, k).astype(jnp.float32) * (hd ** -0.5)
    if rel_table is not None:
        rel = jnp.clip(kpos[None, :] - qpos[:, None], -REL_CLIP, REL_CLIP) + REL_CLIP
        s = s + rel_table[:, rel].astype(jnp.float32).reshape(hkv, g, tq, tk)
    if kvalid is not None:
        s = jnp.where(kvalid, s, MASK_VALUE)
    if sink is not None:
        sk = sink.astype(jnp.float32).reshape(1, hkv, g, 1, 1)
        m = jnp.maximum(jnp.max(s, axis=-1, keepdims=True), sk)
        p = jnp.exp(s - m)
        p = p / (jnp.sum(p, axis=-1, keepdims=True) + jnp.exp(sk - m))
    else:
        p = jax.nn.softmax(s, axis=-1)
    o = jnp.einsum('bhgqk,bkhd->bqhgd', p.astype(v.dtype), v)
    return o.reshape(nb, tq, hq, hd)


def band_prompt(q, k, v, n_past, sink, rel_table):
    nb, s_len, hq, hd = q.shape
    nc = s_len // CHUNK
    pad = n_past * CHUNK
    band = pad + CHUNK
    kp = jnp.pad(k, ((0, 0), (pad, 0), (0, 0), (0, 0)))
    vp = jnp.pad(v, ((0, 0), (pad, 0), (0, 0), (0, 0)))

    def one_chunk(c):
        start = c * CHUNK
        qc = lax.dynamic_slice_in_dim(q, start, CHUNK, axis=1)
        kc = lax.dynamic_slice_in_dim(kp, start, band, axis=1)
        vc = lax.dynamic_slice_in_dim(vp, start, band, axis=1)
        qpos = start + jnp.arange(CHUNK, dtype=jnp.int32)
        kpos = start - pad + jnp.arange(band, dtype=jnp.int32)
        return attend(qc, kc, vc, qpos, kpos, kpos >= 0, sink, rel_table)

    out = lax.map(one_chunk, jnp.arange(nc, dtype=jnp.int32))
    return jnp.transpose(out, (1, 0, 2, 3, 4)).reshape(nb, s_len, hq, hd)


def merge(ya, yb, gate_a, gate_b, w_branch_a, w_branch_b, w_mix_out):
    nb, t = ya.shape[0], ya.shape[1]
    ua = jnp.einsum('bte,ed->btd', ya.reshape(nb, t, Q_A_W), w_branch_a)
    ub = jnp.einsum('bte,ed->btd', yb.reshape(nb, t, Q_B_W), w_branch_b)
    return jnp.einsum('btd,de->bte', gate_a * ua + gate_b * ub, w_mix_out)


def setup_inputs(seed: int = 0) -> dict:
    key = jax.random.key(seed)
    ks = jax.random.split(key, 24)

    def nrm(k, shape, scale):
        return jax.random.normal(k, shape, jnp.float32) * scale

    cache_a = min(WINDOW, PAST_LEN)
    cache_b = min(N_PAST_B * CHUNK, PAST_LEN)
    return {
        'x_prompt': nrm(ks[0], (BATCH, SEQ, D_MODEL), 1.0),
        'x_sample': nrm(ks[1], (DEC_BATCH, DEC_SEQ, D_MODEL), 1.0),
        'cache_k_win': nrm(ks[2], (DEPTH, DEC_BATCH, cache_a, N_KV_A, HEAD_DIM), 1.0),
        'cache_v_win': nrm(ks[3], (DEPTH, DEC_BATCH, cache_a, N_KV_A, HEAD_DIM), 1.0),
        'cache_k_band': nrm(ks[4], (DEPTH, DEC_BATCH, cache_b, N_HEADS_B, HEAD_DIM), 1.0),
        'cache_v_band': nrm(ks[5], (DEPTH, DEC_BATCH, cache_b, N_HEADS_B, HEAD_DIM), 1.0),
        'norm_ffn1': 1.0 + nrm(ks[6], (DEPTH, D_MODEL), 0.02),
        'w_ffn1_in': nrm(ks[7], (DEPTH, D_MODEL, 2 * D_FF), D_MODEL ** -0.5),
        'w_ffn1_out': nrm(ks[8], (DEPTH, D_FF, D_MODEL), D_FF ** -0.5),
        'norm_mix': 1.0 + nrm(ks[9], (DEPTH, D_MODEL), 0.02),
        'w_mix_in': nrm(ks[10], (DEPTH, D_MODEL, D_IN), D_MODEL ** -0.5),
        'b_gate': nrm(ks[11], (DEPTH, 2 * D_MODEL), 0.02),
        'sinks': nrm(ks[12], (DEPTH, N_Q_A), 0.5),
        'rel_bias': nrm(ks[13], (DEPTH, N_HEADS_B, 2 * REL_CLIP + 1), 0.1),
        'w_branch_a': nrm(ks[14], (DEPTH, Q_A_W, D_MODEL), Q_A_W ** -0.5),
        'w_branch_b': nrm(ks[15], (DEPTH, Q_B_W, D_MODEL), Q_B_W ** -0.5),
        'w_mix_out': nrm(ks[16], (DEPTH, D_MODEL, D_MODEL), D_MODEL ** -0.5),
        'norm_ffn2': 1.0 + nrm(ks[17], (DEPTH, D_MODEL), 0.02),
        'w_ffn2_in': nrm(ks[18], (DEPTH, D_MODEL, 2 * D_FF), D_MODEL ** -0.5),
        'w_ffn2_out': nrm(ks[19], (DEPTH, D_FF, D_MODEL), D_FF ** -0.5),
        'norm_final': 1.0 + nrm(ks[20], (D_MODEL,), 0.02),
    }


def reference(x_prompt, x_sample, cache_k_win, cache_v_win, cache_k_band, cache_v_band,
              norm_ffn1, w_ffn1_in, w_ffn1_out, norm_mix, w_mix_in, b_gate, sinks, rel_bias,
              w_branch_a, w_branch_b, w_mix_out, norm_ffn2, w_ffn2_in, w_ffn2_out, norm_final):
    s_len = x_prompt.shape[1]
    t_len = x_sample.shape[1]
    len_a = cache_k_win.shape[2]
    len_b = cache_k_band.shape[2]
    keep_a = min(WINDOW, s_len)
    keep_b = min(N_PAST_B * CHUNK, s_len)
    pos_p = jnp.arange(s_len, dtype=jnp.int32)
    pos_s = PAST_LEN + jnp.arange(t_len, dtype=jnp.int32)
    kpos_a = PAST_LEN - len_a + jnp.arange(len_a + t_len, dtype=jnp.int32)
    kpos_b = PAST_LEN - len_b + jnp.arange(len_b + t_len, dtype=jnp.int32)

    xp, xs = x_prompt, x_sample
    kwp, vwp, kbp, vbp, kws, vws, kbs, vbs = [], [], [], [], [], [], [], []
    for l in range(DEPTH):
        xp = xp + 0.5 * swiglu(rms_norm(xp, norm_ffn1[l]), w_ffn1_in[l], w_ffn1_out[l])
        xs = xs + 0.5 * swiglu(rms_norm(xs, norm_ffn1[l]), w_ffn1_in[l], w_ffn1_out[l])

        qa, ka, va, qb, kb, vb, ga, gb = project(rms_norm(xp, norm_mix[l]), w_mix_in[l], b_gate[l], pos_p)
        ya = band_prompt(qa, ka, va, N_PAST_A, sinks[l], None)
        yb = band_prompt(qb, kb, vb, N_PAST_B, None, rel_bias[l])
        xp = xp + merge(ya, yb, ga, gb, w_branch_a[l], w_branch_b[l], w_mix_out[l])
        kwp.append(ka[:, s_len - keep_a:])
        vwp.append(va[:, s_len - keep_a:])
        kbp.append(kb[:, s_len - keep_b:])
        vbp.append(vb[:, s_len - keep_b:])

        qa, ka, va, qb, kb, vb, ga, gb = project(rms_norm(xs, norm_mix[l]), w_mix_in[l], b_gate[l], pos_s)
        ka_all = jnp.concatenate([cache_k_win[l], ka], axis=1)
        va_all = jnp.concatenate([cache_v_win[l], va], axis=1)
        kb_all = jnp.concatenate([cache_k_band[l], kb], axis=1)
        vb_all = jnp.concatenate([cache_v_band[l], vb], axis=1)
        ya = attend(qa, ka_all, va_all, pos_s, kpos_a, None, sinks[l], None)
        yb = attend(qb, kb_all, vb_all, pos_s, kpos_b, None, None, rel_bias[l])
        xs = xs + merge(ya, yb, ga, gb, w_branch_a[l], w_branch_b[l], w_mix_out[l])
        kws.append(ka_all[:, t_len:])
        vws.append(va_all[:, t_len:])
        kbs.append(kb_all[:, t_len:])
        vbs.append(vb_all[:, t_len:])

        xp = xp + 0.5 * swiglu(rms_norm(xp, norm_ffn2[l]), w_ffn2_in[l], w_ffn2_out[l])
        xs = xs + 0.5 * swiglu(rms_norm(xs, norm_ffn2[l]), w_ffn2_in[l], w_ffn2_out[l])

    y_prompt = rms_norm(xp, norm_final)
    y_sample = rms_norm(xs, norm_final)
    return (y_prompt, y_sample,
            jnp.stack(kwp), jnp.stack(vwp), jnp.stack(kbp), jnp.stack(vbp),
            jnp.stack(kws), jnp.stack(vws), jnp.stack(kbs), jnp.stack(vbs))
```

```cpp
#include <hip/hip_runtime.h>
#include <hip/hip_cooperative_groups.h>
#include <cstdio>
namespace cg = cooperative_groups;

#define LAS __attribute__((address_space(3)))
#define DI __device__ __forceinline__
typedef unsigned short bf16_t;
typedef short bf16x8 __attribute__((ext_vector_type(8)));
typedef short s16x4 __attribute__((ext_vector_type(4)));
typedef float f32x2 __attribute__((ext_vector_type(2)));
typedef float f32x4 __attribute__((ext_vector_type(4)));
typedef float f32x16 __attribute__((ext_vector_type(16)));
typedef unsigned u32x2 __attribute__((ext_vector_type(2)));
typedef unsigned u32x4 __attribute__((ext_vector_type(4)));
typedef __bf16 hbf2 __attribute__((ext_vector_type(2)));

constexpr int TP = 32768, TS = 2048, T = TP + TS, DM = 1024, DFF = 2816, DIN = 4352, NL = 2;
constexpr int NTHR = 512;
constexpr float EPS = 1e-5f;
constexpr float LOG2E = 1.4426950408889634f;
constexpr float QSCALE = 0.125f * LOG2E;

constexpr size_t W1_B = (size_t)2 * DFF * DM * 2, W2_B = (size_t)DM * DFF * 2, W3_B = (size_t)DIN * DM * 2, W4_B = (size_t)2048 * 512 * 2, W5_B = (size_t)DM * DM * 2;
constexpr size_t WO1 = 0, WO2 = WO1 + W1_B, WO3 = WO2 + W2_B, WO4 = WO3 + W3_B, WO5 = WO4 + W4_B, WO6 = WO5 + W5_B, WO7 = WO6 + W1_B, WL_B = WO7 + W2_B;
constexpr size_t WS_W = 0;
constexpr size_t WS_XB = WS_W + NL * WL_B;
constexpr size_t WS_REG = WS_XB + (size_t)T * DM * 2;
constexpr size_t REG_QA = 0, REG_QB = (size_t)T * 512 * 2, REG_MB = 0, REG_GATES = (size_t)T * DM * 2;
constexpr size_t REG_B = (size_t)T * DM * 2 + (size_t)T * 2048 * 2;
constexpr size_t WS_KA = WS_REG + REG_B, WS_VA = WS_KA + (size_t)T * 128 * 2, WS_KB = WS_VA + (size_t)T * 128 * 2, WS_VB = WS_KB + (size_t)T * 512 * 2;
constexpr size_t WS_SS = WS_VB + (size_t)T * 512 * 2;
constexpr size_t WS_ROPE = WS_SS + (size_t)T * 16 * 4;
constexpr size_t WS_BAR = WS_ROPE + (size_t)8256 * 16 * 4;
constexpr size_t WS_CNT = WS_BAR + 16384;
constexpr size_t WS_SLAB = WS_CNT + 18 * 256 * 4;
constexpr size_t WS_END = WS_SLAB + 4096;
static_assert((size_t)T * DFF * 2 <= REG_B, "hidden fits the region");

constexpr size_t O_Y = 0, O_KWP = (size_t)T * DM, O_VWP = O_KWP + 131072, O_KBP = O_VWP + 131072, O_VBP = O_KBP + 2097152,
                 O_KWS = O_VBP + 2097152, O_VWS = O_KWS + 1048576, O_KBS = O_VWS + 1048576, O_VBS = O_KBS + 16777216, O_END = O_VBS + 16777216;

struct Params { const float* in[21]; float* out; unsigned char* ws; };

DI unsigned pk2(float lo, float hi) { f32x2 v = {lo, hi}; hbf2 r = __builtin_convertvector(v, hbf2); return __builtin_bit_cast(unsigned, r); }
DI float fast_exp2(float x) { return __builtin_amdgcn_exp2f(x); }
DI float fast_rcp(float x) { return __builtin_amdgcn_rcpf(x); }

constexpr int BG_OFF = 8 * 128 * 64 * 2 + 64 + 12 * 1024;
constexpr int RS_NTAB = 12, RS_OFF = 8 * 128 * 64 * 2 + 64;
DI float row_rs_g(const float* SS, int row) {
    const f32x4* p = (const f32x4*)(SS + (size_t)row * 16);
    const f32x4 a = p[0], b = p[1], c = p[2], d = p[3];
    const float s = ((a[0] + a[1]) + (a[2] + a[3])) + ((b[0] + b[1]) + (b[2] + b[3])) + ((c[0] + c[1]) + (c[2] + c[3])) + ((d[0] + d[1]) + (d[2] + d[3]));
    return rsqrtf(s * (1.0f / 1024.0f) + 1e-5f);
}
namespace pg8 {
constexpr int BM = 256, BK = 64, HALF = 128, HTB = HALF * BK * 2, STAGE_BYTES = 8 * HTB, NXCD = 8, WGM = 8;
DI int lds_byte(int r, int c) { const int st = (r >> 4) * 2 + (c >> 5), rr = r & 15, cc = c & 31, ob = rr * 64 + cc * 2; return st * 1024 + (ob ^ (((ob >> 9) & 1) << 5)); }
DI void stage_rc(int b, int& R, int& C) { const int st = b / 1024, sb = b % 1024, swz = sb ^ (((sb >> 9) & 1) << 5); R = (st >> 1) * 16 + swz / 64; C = (st & 1) * 32 + (swz % 64) / 2; }
DI int perm32(int rho) { const int n = rho >> 4, i = rho & 15; return 8 * (i >> 2) + 4 * n + (i & 3); }
struct Unit { int pm, pn, kt0, nkt, part, tt, rk; };
struct Gemm { const bf16_t* A; const bf16_t* Bt; int M, N, K; };
constexpr int MAXP = 6;
constexpr int GRID = 256;
template <int M_, int N_, int K_, bool SPLIT, int TAIL = 0>
struct StaticOrder {
    static constexpr int nM = M_ / BM, nN = N_ / BM, nwg = nM * nN, G = GRID, nt = K_ / BK, nfull = nwg / G, rem = nwg % G;
    static constexpr int pmax = (rem > 0 && SPLIT) ? (G / rem < MAXP ? G / rem : MAXP) : 1;
    static constexpr int nparts = pmax < 2 ? 1 : (pmax > nt / 4 ? (nt / 4 < 2 ? 1 : nt / 4) : pmax);
    static constexpr int nrm = TAIL == 0 ? nwg : nfull * G;
    int c; float* slab; unsigned* cnt;
    DI void init(int c_, float* slab_, unsigned* cnt_) { c = c_; slab = slab_; cnt = cnt_; }
    static DI void decode(int L, Unit& u) {
        int wgid = L;
        if (L < nrm) { constexpr int q = nrm / NXCD, r = nrm % NXCD; const int xcd = wgid % NXCD, off = wgid / NXCD; wgid = (xcd < r ? xcd * (q + 1) : r * (q + 1) + (xcd - r) * q) + off; }
        constexpr int nig = WGM * nN; const int gid = wgid / nig, fm = gid * WGM, gsz = (nM - fm) < WGM ? (nM - fm) : WGM;
        u.pm = fm + ((wgid % nig) % gsz); u.pn = (wgid % nig) / gsz;
    }
    DI bool next(int i, Unit& u) const {
        u.kt0 = 0; u.nkt = nt; u.part = -1; u.tt = 0; u.rk = 0;
        if (TAIL == 2) { if (i > 0 || c >= rem) return false; decode(nfull * G + c, u); return true; }
        if (i < nfull) { decode(i * G + c, u); return true; }
        if (TAIL == 1 || i > nfull) return false;
        if (nparts == 1) { if (c >= rem) return false; decode(nfull * G + c, u); return true; }
        if (c >= rem * nparts) return false;
        constexpr int remd = rem > 0 ? rem : 1, pairs = nt / 2, base = pairs / nparts, extra = pairs % nparts;
        const int tt = c % remd, part = c / remd;
        decode(nfull * G + tt, u); u.tt = tt; u.part = part;
        u.kt0 = 2 * (part * base + (part < extra ? part : extra)); u.nkt = 2 * (base + (part < extra ? 1 : 0));
        return true;
    }
};
struct MergeOrder {
    StaticOrder<TP, DM, 512, false> so; static constexpr int nparts = 1; float* slab; unsigned* cnt;
    DI bool next(int i, Unit& u) const { Unit p; if (!so.next(i >> 1, p)) return false; const int s = i & 1; u = p; u.pm = s * (T / BM) + p.pm; u.pn = s * 4 + p.pn; return true; }
};

template <class Epi, class Sched>
DI void gemm_phase(LAS unsigned char* lds, const Gemm g, const Sched& S, const Epi& E) {
    int tid_ = threadIdx.x; asm volatile("" : "+v"(tid_));
    const int tid = tid_, wid = __builtin_amdgcn_readfirstlane(tid >> 6), lane = tid & 63, wr = wid >> 2, wc = wid & 3, fr = lane & 15, fq = lane >> 4;
    const int K = g.K;
    unsigned voffA[2], voffB[2];
#pragma unroll
    for (int i = 0; i < 2; ++i) { int R, C; stage_rc(tid * 16 + i * 8192, R, C); const int Rb = Epi::PERM ? ((R & ~31) + perm32(R & 31)) : R;
        voffA[i] = (unsigned)(R * K + C) * 2u; voffB[i] = (unsigned)(Rb * K + C) * 2u; }
    const size_t kstep = (size_t)(BK * 2);
    const size_t hstep = (size_t)HALF * K * 2;
    const size_t tstep = 2 * hstep;
    const unsigned ldsw = (unsigned)wid * 1024u;
    const int aoff = lds_byte(wr * 64 + fr, fq * 8), boff = lds_byte(wc * 32 + fr, fq * 8);
#define PG8_SA(b, h) (((b) * 2 + (h)) * HTB)
#define PG8_SB(b, h) ((4 + (b) * 2 + (h)) * HTB)
#define PG8_STAGE(bufoff, gbase, voff) do { _Pragma("unroll") for (int _i = 0; _i < 2; ++_i) \
        __builtin_amdgcn_global_load_lds((const unsigned*)((const char*)(gbase) + (voff)[_i]), (LAS unsigned*)(lds + (bufoff) + ldsw + _i * 8192), 16, 0, 0); } while (0)
#define PG8_LDA(dst, b, h) do { _Pragma("unroll") for (int m = 0; m < 4; ++m) _Pragma("unroll") for (int k = 0; k < 2; ++k) dst[m][k] = *(const LAS bf16x8*)(lds + PG8_SA(b, h) + aoff + m * 2048 + k * 1024); } while (0)
#define PG8_LDB(dst, b, h) do { _Pragma("unroll") for (int n = 0; n < 2; ++n) _Pragma("unroll") for (int k = 0; k < 2; ++k) dst[n][k] = *(const LAS bf16x8*)(lds + PG8_SB(b, h) + boff + n * 2048 + k * 1024); } while (0)
#define PG8_MMA(ai, bj, At, Bt) do { __builtin_amdgcn_s_setprio(1); _Pragma("unroll") for (int m = 0; m < 4; ++m) _Pragma("unroll") for (int n = 0; n < 2; ++n) _Pragma("unroll") for (int k = 0; k < 2; ++k) \
        acc[ai][bj][m][n] = __builtin_amdgcn_mfma_f32_16x16x32_bf16(Bt[n][k], At[m][k], acc[ai][bj][m][n], 0, 0, 0); __builtin_amdgcn_s_setprio(0); } while (0)
#define PG8_WAIT_V(n) asm volatile("s_waitcnt vmcnt(" #n ")" ::: "memory")
#define PG8_WAIT_L(n) asm volatile("s_waitcnt lgkmcnt(" #n ")" ::: "memory")
#define PG8_BAR __builtin_amdgcn_s_barrier()
#define PG8_SCHED __builtin_amdgcn_sched_barrier(0)
    Unit cur, nxt; int ui = 0;
    if (!S.next(0, cur)) return;
    if constexpr (Epi::USES_RS) {
        LAS float* tab = (LAS float*)(lds + RS_OFF);
        int k = 0, lastpm = -1; Unit tu;
        for (int i = 0; S.next(i, tu); ++i) {
            if (tu.pm != lastpm) { if ((k & 1) == (tid >> 8) && k < RS_NTAB) tab[k * 256 + (tid & 255)] = row_rs_g(E.ss(), tu.pm * 256 + (tid & 255)); ++k; lastpm = tu.pm; }
        }
        E.phase_init(lds, tid);
        __syncthreads();
    }
    f32x4 acc[2][2][4][2];
#pragma unroll
    for (int a = 0; a < 2; ++a)
#pragma unroll
        for (int b = 0; b < 2; ++b)
#pragma unroll
            for (int m = 0; m < 4; ++m)
#pragma unroll
                for (int n = 0; n < 2; ++n) acc[a][b][m][n] = (f32x4){0.f, 0.f, 0.f, 0.f};
    bf16x8 At[4][2], B0[2][2], B1[2][2];
    const char* cA = (const char*)g.A + (size_t)cur.pm * tstep + (size_t)cur.kt0 * kstep; const char* cB = (const char*)g.Bt + (size_t)cur.pn * tstep + (size_t)cur.kt0 * kstep;
    PG8_STAGE(PG8_SB(0, 0), cB, voffB); PG8_STAGE(PG8_SA(0, 0), cA, voffA); PG8_STAGE(PG8_SB(0, 1), cB + hstep, voffB); PG8_STAGE(PG8_SA(0, 1), cA + hstep, voffA);
    if (wr == 1) PG8_BAR;
    PG8_WAIT_V(4); PG8_BAR;
    PG8_STAGE(PG8_SB(1, 0), cB + kstep, voffB); PG8_STAGE(PG8_SA(1, 0), cA + kstep, voffA); PG8_STAGE(PG8_SB(1, 1), cB + hstep + kstep, voffB);
    PG8_WAIT_V(6); PG8_BAR;
    for (;;) {
        const bool has_next = S.next(ui + 1, nxt);
        const char* nA = has_next ? (const char*)g.A + (size_t)nxt.pm * tstep + (size_t)nxt.kt0 * kstep : cA; const char* nB = has_next ? (const char*)g.Bt + (size_t)nxt.pn * tstep + (size_t)nxt.kt0 * kstep : cB;
        const int nt = cur.nkt;
        for (int t = 0; t < nt; t += 2) {
            const bool last = (t == nt - 2);
            const char* a1 = cA + (size_t)(t + 1) * kstep;
            const char* a2 = last ? nA : cA + (size_t)(t + 2) * kstep; const char* b2 = last ? nB : cB + (size_t)(t + 2) * kstep;
            const char* a3 = a2 + kstep; const char* b3 = b2 + kstep;
            PG8_LDB(B0, 0, 0); PG8_SCHED; PG8_LDA(At, 0, 0); PG8_STAGE(PG8_SA(1, 1), a1 + hstep, voffA);
            PG8_WAIT_L(8); PG8_BAR; PG8_WAIT_L(0); PG8_MMA(0, 0, At, B0); PG8_BAR; PG8_SCHED;
            PG8_LDB(B1, 0, 1); PG8_STAGE(PG8_SB(0, 0), b2, voffB);
            PG8_BAR; PG8_WAIT_L(0); PG8_MMA(0, 1, At, B1); PG8_BAR;
            PG8_LDA(At, 0, 1); PG8_STAGE(PG8_SA(0, 0), a2, voffA);
            PG8_BAR; PG8_WAIT_L(0); PG8_MMA(1, 0, At, B0); PG8_BAR; PG8_SCHED;
            PG8_STAGE(PG8_SB(0, 1), b2 + hstep, voffB);
            PG8_WAIT_V(6); PG8_BAR; PG8_MMA(1, 1, At, B1); PG8_BAR;
            PG8_LDB(B0, 1, 0); PG8_SCHED; PG8_LDA(At, 1, 0); PG8_STAGE(PG8_SA(0, 1), a2 + hstep, voffA);
            PG8_WAIT_L(8); PG8_BAR; PG8_WAIT_L(0); PG8_MMA(0, 0, At, B0); PG8_BAR; PG8_SCHED;
            PG8_LDB(B1, 1, 1); PG8_STAGE(PG8_SB(1, 0), b3, voffB);
            PG8_BAR; PG8_WAIT_L(0); PG8_MMA(0, 1, At, B1); PG8_BAR;
            PG8_LDA(At, 1, 1); PG8_STAGE(PG8_SA(1, 0), a3, voffA);
            PG8_BAR; PG8_WAIT_L(0); PG8_MMA(1, 0, At, B0); PG8_BAR; PG8_SCHED;
            PG8_STAGE(PG8_SB(1, 1), b3 + hstep, voffB);
            PG8_WAIT_V(6); PG8_BAR; PG8_MMA(1, 1, At, B1); PG8_BAR;
        }
        if (cur.part < 0) E(acc, cur, wr, wc, fr, fq, lds);
        if (!has_next) break;
        if (!E.keep(cur)) {
#pragma unroll
            for (int a = 0; a < 2; ++a)
#pragma unroll
                for (int b = 0; b < 2; ++b)
#pragma unroll
                    for (int m = 0; m < 4; ++m)
#pragma unroll
                        for (int n = 0; n < 2; ++n) acc[a][b][m][n] = (f32x4){0.f, 0.f, 0.f, 0.f};
        }
        nxt.rk = cur.rk + (nxt.pm != cur.pm ? 1 : 0);
        cur = nxt; cA = nA; cB = nB; ++ui;
    }
    PG8_WAIT_V(0);
    if (wr == 0) PG8_BAR;
    PG8_BAR;
    {
      if (Sched::nparts > 1 && cur.part >= 0) {
        constexpr int np = Sched::nparts;
        float* sl = S.slab + (size_t)(cur.tt * np) * 65536 + (size_t)tid * 4;
        { float* mine = sl + (size_t)cur.part * 65536;
#pragma unroll
          for (int a = 0; a < 2; ++a)
#pragma unroll
            for (int b = 0; b < 2; ++b)
#pragma unroll
                for (int m = 0; m < 4; ++m)
#pragma unroll
                    for (int n = 0; n < 2; ++n) *(f32x4*)(mine + (size_t)(((a * 2 + b) * 4 + m) * 2 + n) * 2048) = acc[a][b][m][n]; }
        asm volatile("s_waitcnt vmcnt(0)" ::: "memory");
        __syncthreads();
        volatile LAS unsigned* flag = (volatile LAS unsigned*)(lds + STAGE_BYTES + 8);
        if (tid == 0) {
            __builtin_amdgcn_fence(__ATOMIC_RELEASE, "agent");
            asm volatile("s_waitcnt vmcnt(0)" ::: "memory");
            const unsigned old = __hip_atomic_fetch_add(S.cnt + cur.tt, 1u, __ATOMIC_RELAXED, __HIP_MEMORY_SCOPE_AGENT);
            if (old == (unsigned)(np - 1)) { __builtin_amdgcn_fence(__ATOMIC_ACQUIRE, "agent"); asm volatile("s_waitcnt vmcnt(0)" ::: "memory"); }
            flag[0] = old;
        }
        __syncthreads();
        const unsigned old = flag[0];
        if (old == (unsigned)(np - 1)) {
            for (int p = 0; p < np; ++p) {
                if (p == cur.part) continue;
                const float* oth = sl + (size_t)p * 65536;
#pragma unroll
                for (int a = 0; a < 2; ++a)
#pragma unroll
                    for (int b = 0; b < 2; ++b) {
#pragma unroll
                        for (int m = 0; m < 4; ++m)
#pragma unroll
                            for (int n = 0; n < 2; ++n) acc[a][b][m][n] += *(const f32x4*)(oth + (size_t)(((a * 2 + b) * 4 + m) * 2 + n) * 2048);
                        asm volatile("" ::: "memory");
                    }
            }
            E(acc, cur, wr, wc, fr, fq, lds);
        }
        __syncthreads();
      }
    }
#undef PG8_SA
#undef PG8_SB
#undef PG8_STAGE
#undef PG8_LDA
#undef PG8_LDB
#undef PG8_MMA
#undef PG8_WAIT_V
#undef PG8_WAIT_L
#undef PG8_BAR
#undef PG8_SCHED
}
}
using pg8::Unit;

DI float row_rs(const float* SS, int row) {
    const f32x4* p = (const f32x4*)(SS + (size_t)row * 16);
    const f32x4 a = p[0], b = p[1], c = p[2], d = p[3];
    const float s = ((a[0] + a[1]) + (a[2] + a[3])) + ((b[0] + b[1]) + (b[2] + b[3])) + ((c[0] + c[1]) + (c[2] + c[3])) + ((d[0] + d[1]) + (d[2] + d[3]));
    return rsqrtf(s * (1.0f / 1024.0f) + EPS);
}
DI float row_rs4(const float* SS, int row, int fq) {
    const f32x4 a = *(const f32x4*)(SS + (size_t)row * 16 + 4 * fq);
    float s = (a[0] + a[1]) + (a[2] + a[3]);
    s += __shfl_xor(s, 16); s += __shfl_xor(s, 32);
    return rsqrtf(s * (1.0f / 1024.0f) + EPS);
}
DI float silu_mul(float a, float b) { return a * fast_rcp(1.0f + fast_exp2(-a * LOG2E)) * b; }
DI float sigmoidf_(float a) { return fast_rcp(1.0f + fast_exp2(-a * LOG2E)); }

struct EpiSwiglu {
    static constexpr bool PERM = true, USES_RS = true;
    bf16_t* H; const float* SS;
    DI const float* ss() const { return SS; }
    DI void phase_init(LAS unsigned char*, int) const {}
    DI bool keep(const Unit&) const { return false; }
    DI void operator()(f32x4 (&acc)[2][2][4][2], const Unit& u, int wr, int wc, int fr, int fq, LAS unsigned char* lds) const {
        const int row0 = u.pm * 256 + wr * 64 + fr, hc = u.pn * 128 + wc * 32 + 8 * fq;
        float rsv[8];
        { const LAS float* tab = (const LAS float*)(lds + RS_OFF) + u.rk * 256 + wr * 64 + fr;
#pragma unroll
          for (int i = 0; i < 8; ++i) rsv[i] = tab[(i >> 2) * 128 + (i & 3) * 16]; }
#pragma unroll
        for (int ai = 0; ai < 2; ++ai)
#pragma unroll
            for (int m = 0; m < 4; ++m) {
                const int row = row0 + ai * 128 + m * 16; const float rs = rsv[ai * 4 + m];
                const f32x4 a0 = acc[ai][0][m][0] * rs, a1 = acc[ai][0][m][1] * rs, b0 = acc[ai][1][m][0] * rs, b1 = acc[ai][1][m][1] * rs;
                u32x4 w;
                w.x = pk2(silu_mul(a0[0], b0[0]), silu_mul(a0[1], b0[1])); w.y = pk2(silu_mul(a0[2], b0[2]), silu_mul(a0[3], b0[3]));
                w.z = pk2(silu_mul(a1[0], b1[0]), silu_mul(a1[1], b1[1])); w.w = pk2(silu_mul(a1[2], b1[2]), silu_mul(a1[3], b1[3]));
                *(u32x4*)(H + (size_t)row * DFF + hc) = w;
            }
    }
};

struct EpiResid {
    static constexpr bool PERM = false, USES_RS = false;
    const float* xin_p; const float* xin_s; float* X; bf16_t* XB; float* SS; float scale; bool wxb;
    DI bool keep(const Unit&) const { return false; }
    DI void operator()(f32x4 (&acc)[2][2][4][2], const Unit& u, int wr, int wc, int fr, int fq, LAS unsigned char* lds) const {
        const int row0 = u.pm * 256 + wr * 64 + fr, col0 = u.pn * 256 + wc * 32 + 4 * fq;
#pragma unroll
        for (int ai = 0; ai < 2; ++ai) {
            f32x4 xv[4][2][2];
#pragma unroll
            for (int m = 0; m < 4; ++m) {
                const int row = row0 + ai * 128 + m * 16;
                const float* xi = (row < TP ? xin_p + (size_t)row * DM : xin_s + (size_t)(row - TP) * DM) + col0;
#pragma unroll
                for (int bj = 0; bj < 2; ++bj)
#pragma unroll
                    for (int n = 0; n < 2; ++n) xv[m][bj][n] = *(const f32x4*)(xi + bj * 128 + n * 16);
            }
#pragma unroll
            for (int m = 0; m < 4; ++m) {
                const int row = row0 + ai * 128 + m * 16;
                float* xo = X + (size_t)row * DM + col0; bf16_t* xb = XB + (size_t)row * DM + col0;
                float ssq = 0.f;
#pragma unroll
                for (int bj = 0; bj < 2; ++bj)
#pragma unroll
                    for (int n = 0; n < 2; ++n) {
                        const int c = bj * 128 + n * 16;
                        const f32x4 o = xv[m][bj][n] + acc[ai][bj][m][n] * scale;
                        *(f32x4*)(xo + c) = o;
                        if (wxb) { u32x2 w; w.x = pk2(o[0], o[1]); w.y = pk2(o[2], o[3]); *(u32x2*)(xb + c) = w; }
                        ssq += (o[0] * o[0] + o[1] * o[1]) + (o[2] * o[2] + o[3] * o[3]);
                    }
                ssq += __shfl_xor(ssq, 16); ssq += __shfl_xor(ssq, 32);
                if (fq == 0) SS[(size_t)row * 16 + u.pn * 4 + wc] = ssq;
            }
        }
    }
};

struct EpiProj {
    static constexpr bool PERM = true, USES_RS = true;
    DI const float* ss() const { return (const float*)(ws + WS_SS); }
    DI void phase_init(LAS unsigned char* lds, int tid) const { *(LAS f32x4*)(lds + BG_OFF + tid * 16) = *(const f32x4*)(bgate + tid * 4); }
    unsigned char* ws; const float* bgate; float* out; int layer;
    DI bool keep(const Unit&) const { return false; }
    DI void operator()(f32x4 (&acc)[2][2][4][2], const Unit& u, int wr, int wc, int fr, int fq, LAS unsigned char* lds) const {
        bf16_t* const QA = (bf16_t*)(ws + WS_REG + REG_QA); bf16_t* const QB = (bf16_t*)(ws + WS_REG + REG_QB); bf16_t* const GATES = (bf16_t*)(ws + WS_REG + REG_GATES);
        bf16_t* const KA = (bf16_t*)(ws + WS_KA); bf16_t* const VA = (bf16_t*)(ws + WS_VA); bf16_t* const KB = (bf16_t*)(ws + WS_KB); bf16_t* const VB = (bf16_t*)(ws + WS_VB);
        const float* const ROPE = (const float*)(ws + WS_ROPE);
        const int row0 = u.pm * 256 + wr * 64 + fr, cw = wc * 32 + 8 * fq;
        const bool rope_wave = (wc & 1) == 0;
        float rsv[8];
        { const LAS float* tab = (const LAS float*)(lds + RS_OFF) + u.rk * 256 + wr * 64 + fr;
#pragma unroll
          for (int i = 0; i < 8; ++i) rsv[i] = tab[(i >> 2) * 128 + (i & 3) * 16]; }
#pragma unroll
        for (int ai = 0; ai < 2; ++ai)
#pragma unroll
            for (int m = 0; m < 4; ++m) {
                const int row = row0 + ai * 128 + m * 16; const float rs = rsv[ai * 4 + m];
                int posidx; long offA, offB;
                const bool prm = row < TP;
                if (prm) { const int b = row >> 13, t = row & 8191; posidx = t;
                    offA = t >= 8064 ? ((long)(layer * 4 + b) * 128 + (t - 8064)) * 128 : -1;
                    offB = t >= 7680 ? ((long)(layer * 4 + b) * 512 + (t - 7680)) * 512 : -1;
                } else { const int sb = (row - TP) >> 6, t = (row - TP) & 63; posidx = 8192 + t;
                    offA = ((long)(layer * 32 + sb) * 128 + 64 + t) * 128;
                    offB = ((long)(layer * 32 + sb) * 512 + 448 + t) * 512; }
#pragma unroll
                for (int bj = 0; bj < 2; ++bj) {
                    const int gcol = u.pn * 256 + bj * 128;
                    f32x4 v0 = acc[ai][bj][m][0] * rs, v1 = acc[ai][bj][m][1] * rs;
                    if (gcol < 768 && gcol != 640) {
                        if (rope_wave) {
                            const float* rp = ROPE + (size_t)posidx * 16;
                            const f32x4 cs0 = *(const f32x4*)rp, cs1 = *(const f32x4*)(rp + 4), sn0 = *(const f32x4*)(rp + 8), sn1 = *(const f32x4*)(rp + 12);
                            f32x4 p0, p1;
#pragma unroll
                            for (int j = 0; j < 4; ++j) { p0[j] = __shfl_xor(v0[j], 16); p1[j] = __shfl_xor(v1[j], 16); }
                            if (fq == 0) { v0 = v0 * cs0 - p0 * sn0; v1 = v1 * cs1 - p1 * sn1; }
                            else if (fq == 1) { v0 = v0 * cs0 + p0 * sn0; v1 = v1 * cs1 + p1 * sn1; }
                        }
                    }
                    bf16_t* dst; int ld, c0; float* of = nullptr; long orow = -1;
                    if (gcol < 512) { dst = QA; ld = 512; c0 = gcol; v0 = v0 * QSCALE; v1 = v1 * QSCALE; }
                    else if (gcol < 640) { dst = KA; ld = 128; c0 = gcol - 512; of = out + (prm ? O_KWP : O_KWS); orow = offA; }
                    else if (gcol < 768) { dst = VA; ld = 128; c0 = gcol - 640; of = out + (prm ? O_VWP : O_VWS); orow = offA; }
                    else if (gcol < 1280) { dst = QB; ld = 512; c0 = gcol - 768; v0 = v0 * QSCALE; v1 = v1 * QSCALE; }
                    else if (gcol < 1792) { dst = KB; ld = 512; c0 = gcol - 1280; of = out + (prm ? O_KBP : O_KBS); orow = offB; }
                    else if (gcol < 2304) { dst = VB; ld = 512; c0 = gcol - 1792; of = out + (prm ? O_VBP : O_VBS); orow = offB; }
                    else { dst = GATES; ld = 2048; c0 = gcol - 2304;
                        const f32x4 g0 = *(const LAS f32x4*)(lds + BG_OFF + (c0 + cw) * 4), g1 = *(const LAS f32x4*)(lds + BG_OFF + (c0 + cw + 4) * 4);
#pragma unroll
                        for (int j = 0; j < 4; ++j) { v0[j] = sigmoidf_(v0[j] + g0[j]); v1[j] = sigmoidf_(v1[j] + g1[j]); } }
                    u32x4 w; w.x = pk2(v0[0], v0[1]); w.y = pk2(v0[2], v0[3]); w.z = pk2(v1[0], v1[1]); w.w = pk2(v1[2], v1[3]);
                    *(u32x4*)(dst + (size_t)row * ld + c0 + cw) = w;
                    if (of != nullptr && orow >= 0) { float* op = of + orow + c0 + cw; *(f32x4*)op = v0; *(f32x4*)(op + 4) = v1; }
                }
            }
    }
};

struct EpiMerge {
    static constexpr bool PERM = true, USES_RS = false;
    const bf16_t* GATES; bf16_t* MB;
    DI bool keep(const Unit& u) const { return u.pm < T / 256; }
    DI void operator()(f32x4 (&acc)[2][2][4][2], const Unit& u, int wr, int wc, int fr, int fq, LAS unsigned char* lds) const {
        const int s = u.pm >= T / 256 ? 1 : 0;
        const int row0 = (u.pm - s * (T / 256)) * 256 + wr * 64 + fr, col0 = (u.pn - s * 4) * 256 + wc * 32 + 8 * fq;
#pragma unroll
        for (int ai = 0; ai < 2; ++ai) {
            u32x4 gbv[4][2], gav[4][2];
#pragma unroll
            for (int m = 0; m < 4; ++m) {
                const bf16_t* gp = GATES + (size_t)(row0 + ai * 128 + m * 16) * 2048 + col0;
#pragma unroll
                for (int bj = 0; bj < 2; ++bj) { gbv[m][bj] = *(const u32x4*)(gp + 1024 + bj * 128); if (s == 0) gav[m][bj] = *(const u32x4*)(gp + bj * 128); }
            }
#pragma unroll
            for (int m = 0; m < 4; ++m) {
                const int row = row0 + ai * 128 + m * 16;
#pragma unroll
                for (int bj = 0; bj < 2; ++bj) {
                    const u32x4 gb = gbv[m][bj];
                    float gbf[8];
#pragma unroll
                    for (int q = 0; q < 4; ++q) { gbf[2 * q] = __uint_as_float(gb[q] << 16); gbf[2 * q + 1] = __uint_as_float(gb[q] & 0xffff0000u); }
                    if (s == 0) {
                        const u32x4 ga = gav[m][bj];
#pragma unroll
                        for (int q = 0; q < 4; ++q) {
                            const float a0 = __uint_as_float(ga[q] << 16), a1 = __uint_as_float(ga[q] & 0xffff0000u);
                            const int n = q >> 1, j = (q & 1) * 2;
                            acc[ai][bj][m][n][j] *= a0 * fast_rcp(gbf[2 * q]); acc[ai][bj][m][n][j + 1] *= a1 * fast_rcp(gbf[2 * q + 1]);
                        }
                    } else {
                        u32x4 w;
#pragma unroll
                        for (int q = 0; q < 4; ++q) { const int n = q >> 1, j = (q & 1) * 2; w[q] = pk2(acc[ai][bj][m][n][j] * gbf[2 * q], acc[ai][bj][m][n][j + 1] * gbf[2 * q + 1]); }
                        *(u32x4*)(MB + (size_t)row * DM + col0 + bj * 128) = w;
                    }
                }
            }
        }
    }
};

constexpr int SM_STAGE = 24576, SM_NST = 5, SM_PART = SM_NST * SM_STAGE;
DI void small_kloop(LAS unsigned char* lds, f32x16& acc, const bf16_t* Ap, const bf16_t* Bp, int K, int nkt, int tid, int wm, int wn, int ql, int h) {
    const int wv = tid >> 6, l = tid & 63, r8 = l >> 3, p = l & 7;
    const char* ga = (const char*)(Ap + (size_t)(8 * wv + r8) * K) + ((p ^ r8) << 4);
    const char* gb0 = (const char*)(Bp + (size_t)(8 * wv + r8) * K) + ((p ^ r8) << 4);
    const char* gb1 = (const char*)(Bp + (size_t)(64 + 8 * wv + r8) * K) + ((p ^ r8) << 4);
    const unsigned la = (unsigned)wv * 1024u, lb0 = 8192u + (unsigned)wv * 1024u, lb1 = 8192u + 8192u + (unsigned)wv * 1024u;
#define SM_ISSUE(kt_, slot_) do { const int _k = (kt_) < nkt ? (kt_) : nkt - 1; LAS unsigned char* _st = lds + (slot_) * SM_STAGE; \
        __builtin_amdgcn_global_load_lds((const unsigned*)(ga + (size_t)_k * 128), (LAS unsigned*)(_st + la), 16, 0, 0); \
        __builtin_amdgcn_global_load_lds((const unsigned*)(gb0 + (size_t)_k * 128), (LAS unsigned*)(_st + lb0), 16, 0, 0); \
        __builtin_amdgcn_global_load_lds((const unsigned*)(gb1 + (size_t)_k * 128), (LAS unsigned*)(_st + lb1), 16, 0, 0); } while (0)
    __syncthreads();
    SM_ISSUE(0, 0); SM_ISSUE(1, 1); SM_ISSUE(2, 2); SM_ISSUE(3, 3);
    const int ra = 32 * wm + ql, rb = 32 * wn + ql;
    const unsigned aoff = (unsigned)ra * 128u, boff = 8192u + (unsigned)rb * 128u, sa = (unsigned)(ra & 7), sb = (unsigned)(rb & 7);
    int slot = 0, islot = 4;
#pragma nounroll
    for (int kt = 0; kt < nkt; ++kt) {
        asm volatile("s_waitcnt vmcnt(9)" ::: "memory");
        __builtin_amdgcn_s_barrier();
        asm volatile("" ::: "memory");
        SM_ISSUE(kt + 4, islot);
        const LAS unsigned char* st = lds + slot * SM_STAGE;
#pragma unroll
        for (int s = 0; s < 4; ++s) {
            const bf16x8 a = *(const LAS bf16x8*)(st + aoff + (((unsigned)(2 * s + h) ^ sa) << 4));
            const bf16x8 b = *(const LAS bf16x8*)(st + boff + (((unsigned)(2 * s + h) ^ sb) << 4));
            acc = __builtin_amdgcn_mfma_f32_32x32x16_bf16(a, b, acc, 0, 0, 0);
        }
        islot = slot; slot = slot == SM_NST - 1 ? 0 : slot + 1;
    }
    asm volatile("s_waitcnt vmcnt(0)" ::: "memory");
    __builtin_amdgcn_s_barrier();
    asm volatile("" ::: "memory");
#undef SM_ISSUE
}
DI void small_resid(LAS unsigned char* lds, const bf16_t* A, const bf16_t* Bt, int K, const float* xin, float* X, bf16_t* XB, float* SS, float scale, bool wxb = true) {
    int tid_ = threadIdx.x; asm volatile("" : "+v"(tid_));
    const int tid = tid_, wid = __builtin_amdgcn_readfirstlane(tid >> 6), lane = tid & 63, wm = wid >> 2, wn = wid & 3, ql = lane & 31, h = lane >> 5;
    for (int u = blockIdx.x; u < 256; u += gridDim.x) {
        const int tm = u >> 3, tn = u & 7;
        f32x16 acc;
#pragma unroll
        for (int r = 0; r < 16; ++r) acc[r] = 0.f;
        small_kloop(lds, acc, A + (size_t)(tm * 64) * K, Bt + (size_t)(tn * 128) * K, K, K / 64, tid, wm, wn, ql, h);
        LAS float* part = (LAS float*)(lds + SM_PART);
        const int col = tn * 128 + 32 * wn + ql;
#pragma unroll
        for (int r = 0; r < 16; ++r) {
            const int rl = 32 * wm + (r & 3) + 8 * (r >> 2) + 4 * h; const size_t e = (size_t)(tm * 64 + rl) * DM + col;
            const float o = xin[e] + scale * acc[r];
            X[e] = o; if (wxb) XB[e] = (bf16_t)(pk2(o, 0.f) & 0xffffu);
            float q = o * o;
            q += __shfl_xor(q, 1); q += __shfl_xor(q, 2); q += __shfl_xor(q, 4); q += __shfl_xor(q, 8); q += __shfl_xor(q, 16);
            if (ql == 0) part[rl * 4 + wn] = q;
        }
        __syncthreads();
        if (tid < 128) { const int rl = tid >> 1, pr = tid & 1; SS[(size_t)(tm * 64 + rl) * 16 + tn * 2 + pr] = part[rl * 4 + 2 * pr] + part[rl * 4 + 2 * pr + 1]; }
    }
    __syncthreads();
}
DI void small_merge(LAS unsigned char* lds, const bf16_t* YA, const bf16_t* YB, const bf16_t* W4, const bf16_t* GATES, bf16_t* MB) {
    int tid_ = threadIdx.x; asm volatile("" : "+v"(tid_));
    const int tid = tid_, wid = __builtin_amdgcn_readfirstlane(tid >> 6), lane = tid & 63, wm = wid >> 2, wn = wid & 3, ql = lane & 31, h = lane >> 5;
    for (int u = blockIdx.x; u < 256; u += gridDim.x) {
        const int tm = u >> 3, tn = u & 7;
        f32x16 acc, acc2;
#pragma unroll
        for (int r = 0; r < 16; ++r) { acc[r] = 0.f; acc2[r] = 0.f; }
        small_kloop(lds, acc, YA + (size_t)(tm * 64) * 512, W4 + (size_t)(tn * 128) * 512, 512, 8, tid, wm, wn, ql, h);
        small_kloop(lds, acc2, YB + (size_t)(tm * 64) * 512, W4 + (size_t)(1024 + tn * 128) * 512, 512, 8, tid, wm, wn, ql, h);
        const int col = tn * 128 + 32 * wn + ql;
#pragma unroll
        for (int r = 0; r < 16; ++r) {
            const int rl = 32 * wm + (r & 3) + 8 * (r >> 2) + 4 * h; const size_t row = (size_t)(tm * 64 + rl);
            const float ga = __uint_as_float((unsigned)GATES[row * 2048 + col] << 16), gb = __uint_as_float((unsigned)GATES[row * 2048 + 1024 + col] << 16);
            MB[row * DM + col] = (bf16_t)(pk2(ga * acc[r] + gb * acc2[r], 0.f) & 0xffffu);
        }
    }
    __syncthreads();
}

DI void tr_job(LAS float* tile, const float* __restrict__ src, bf16_t* __restrict__ dst, const float* __restrict__ g, int K, int N, int perm, int& tbase) {
    const int G = gridDim.x, nk = K / 64, ntile = nk * (N / 64), tid = threadIdx.x;
    int first = ((int)blockIdx.x - tbase % G) % G; if (first < 0) first += G;
    for (int t = first; t < ntile; t += G) {
        const int tn = t / nk, tk = t % nk; const int nb = tn * 64;
        const int scol = perm ? (((nb & 255) < 128) ? (nb >> 8) * 128 + (nb & 255) : DFF + (nb >> 8) * 128 + (nb & 255) - 128) : nb;
        const int ty = tid >> 4, tx = tid & 15;
#pragma unroll
        for (int i = 0; i < 2; ++i) { const int k = ty + 32 * i; f32x4 v = *(const f32x4*)(src + (size_t)(tk * 64 + k) * N + scol + 4 * tx);
            if (g) v = v * g[tk * 64 + k];
            tile[k * 65 + 4 * tx] = v[0]; tile[k * 65 + 4 * tx + 1] = v[1]; tile[k * 65 + 4 * tx + 2] = v[2]; tile[k * 65 + 4 * tx + 3] = v[3]; }
        __syncthreads();
        { const int n = tid >> 3, kp = tid & 7; float e[8];
#pragma unroll
          for (int j = 0; j < 8; ++j) e[j] = tile[(8 * kp + j) * 65 + n];
          u32x4 w; w.x = pk2(e[0], e[1]); w.y = pk2(e[2], e[3]); w.z = pk2(e[4], e[5]); w.w = pk2(e[6], e[7]);
          *(u32x4*)(dst + (size_t)(nb + n) * K + tk * 64 + 8 * kp) = w; }
        __syncthreads();
    }
    tbase += ntile;
}

DI void sincos_d(double a, float& c, float& s) {
    const double k = rint(a * 0.63661977236758134308);
    const double r = (a - k * 1.57079632679489655800) - k * 6.12323399573676603587e-17;
    const double r2 = r * r;
    const double sp = r * (1.0 + r2 * (-1.0 / 6 + r2 * (1.0 / 120 + r2 * (-1.0 / 5040 + r2 * (1.0 / 362880 + r2 * (-1.0 / 39916800 + r2 * (1.0 / 6227020800.0)))))));
    const double cp = 1.0 + r2 * (-0.5 + r2 * (1.0 / 24 + r2 * (-1.0 / 720 + r2 * (1.0 / 40320 + r2 * (-1.0 / 3628800 + r2 * (1.0 / 479001600.0 + r2 * (-1.0 / 87178291200.0)))))));
    const int q = ((int)k) & 3;
    const double sv = (q == 0) ? sp : (q == 1) ? cp : (q == 2) ? -sp : -cp;
    const double cv = (q == 0) ? cp : (q == 1) ? -sp : (q == 2) ? -cp : sp;
    c = (float)cv; s = (float)sv;
}

DI void prologue(const Params& P, LAS unsigned char* lds) {
    const int tid = threadIdx.x, G = gridDim.x, bid = blockIdx.x, lane = tid & 63, wid = tid >> 6;
    unsigned char* ws = P.ws;
    { LAS float* tile = (LAS float*)lds;
      constexpr int NT1 = (DM / 64) * (2 * DFF / 64), NT2 = (DFF / 64) * (DM / 64), NT3 = (DM / 64) * (DIN / 64), NT4 = (512 / 64) * (DM / 64), NT5 = (DM / 64) * (DM / 64);
      constexpr int C1 = NT1, C2 = C1 + NT2, C3 = C2 + NT3, C4 = C3 + NT4, C5 = C4 + NT4, C6 = C5 + NT5, C7 = C6 + NT1, C8 = C7 + NT2;
      const int ty = tid >> 4, tx = tid & 15, sn = tid >> 3, skp = tid & 7;
      const float* s0; const float* gp; bf16_t* dp; int sN;
      f32x4 v0 = {0.f, 0.f, 0.f, 0.f}, v1 = v0; float g0 = 1.f, g1 = 1.f;
#define TR_ADDR(t_, s0_, gp_, dp_, sN_) do { const int _l = (t_) / C8, _r = (t_) % C8; unsigned char* _wl = ws + WS_W + (size_t)_l * WL_B; \
        const float* _src; bf16_t* _dst; const float* _g = nullptr; int _K, _N, _perm = 0, _loc; \
        if (_r < C1) { _src = P.in[7] + (size_t)_l * DM * 2 * DFF; _dst = (bf16_t*)(_wl + WO1); _g = P.in[6] + _l * DM; _K = DM; _N = 2 * DFF; _perm = 1; _loc = _r; } \
        else if (_r < C2) { _src = P.in[8] + (size_t)_l * DFF * DM; _dst = (bf16_t*)(_wl + WO2); _K = DFF; _N = DM; _loc = _r - C1; } \
        else if (_r < C3) { _src = P.in[10] + (size_t)_l * DM * DIN; _dst = (bf16_t*)(_wl + WO3); _g = P.in[9] + _l * DM; _K = DM; _N = DIN; _loc = _r - C2; } \
        else if (_r < C4) { _src = P.in[14] + (size_t)_l * 512 * DM; _dst = (bf16_t*)(_wl + WO4); _K = 512; _N = DM; _loc = _r - C3; } \
        else if (_r < C5) { _src = P.in[15] + (size_t)_l * 512 * DM; _dst = (bf16_t*)(_wl + WO4) + (size_t)1024 * 512; _K = 512; _N = DM; _loc = _r - C4; } \
        else if (_r < C6) { _src = P.in[16] + (size_t)_l * DM * DM; _dst = (bf16_t*)(_wl + WO5); _K = DM; _N = DM; _loc = _r - C5; } \
        else if (_r < C7) { _src = P.in[18] + (size_t)_l * DM * 2 * DFF; _dst = (bf16_t*)(_wl + WO6); _g = P.in[17] + _l * DM; _K = DM; _N = 2 * DFF; _perm = 1; _loc = _r - C6; } \
        else { _src = P.in[19] + (size_t)_l * DFF * DM; _dst = (bf16_t*)(_wl + WO7); _K = DFF; _N = DM; _loc = _r - C7; } \
        const int _nk = _K / 64, _tn = _loc / _nk, _tk = _loc % _nk, _nb = _tn * 64; \
        const int _scol = _perm ? (((_nb & 255) < 128) ? (_nb >> 8) * 128 + (_nb & 255) : DFF + (_nb >> 8) * 128 + (_nb & 255) - 128) : _nb; \
        s0_ = _src + (size_t)(_tk * 64 + ty) * _N + _scol + 4 * tx; gp_ = _g ? _g + _tk * 64 + ty : nullptr; sN_ = _N; \
        dp_ = _dst + (size_t)(_nb + sn) * _K + _tk * 64 + 8 * skp; } while (0)
#define TR_BAR() do { asm volatile("s_waitcnt lgkmcnt(0)" ::: "memory"); __builtin_amdgcn_s_barrier(); asm volatile("" ::: "memory"); } while (0)
      int t = bid;
      if (t < NL * C8) { TR_ADDR(t, s0, gp, dp, sN); v0 = *(const f32x4*)s0; v1 = *(const f32x4*)(s0 + (size_t)32 * sN); if (gp) { g0 = gp[0]; g1 = gp[32]; } }
      while (t < NL * C8) {
          const f32x4 a = v0 * g0, b = v1 * g1;
          bf16_t* const dcur = dp;
          const int tn_ = t + G; g0 = 1.f; g1 = 1.f;
          if (tn_ < NL * C8) { TR_ADDR(tn_, s0, gp, dp, sN); v0 = *(const f32x4*)s0; v1 = *(const f32x4*)(s0 + (size_t)32 * sN); if (gp) { g0 = gp[0]; g1 = gp[32]; } }
          tile[ty * 65 + 4 * tx] = a[0]; tile[ty * 65 + 4 * tx + 1] = a[1]; tile[ty * 65 + 4 * tx + 2] = a[2]; tile[ty * 65 + 4 * tx + 3] = a[3];
          tile[(ty + 32) * 65 + 4 * tx] = b[0]; tile[(ty + 32) * 65 + 4 * tx + 1] = b[1]; tile[(ty + 32) * 65 + 4 * tx + 2] = b[2]; tile[(ty + 32) * 65 + 4 * tx + 3] = b[3];
          TR_BAR();
          { float e[8];
#pragma unroll
            for (int j = 0; j < 8; ++j) e[j] = tile[(8 * skp + j) * 65 + sn];
            u32x4 w; w.x = pk2(e[0], e[1]); w.y = pk2(e[2], e[3]); w.z = pk2(e[4], e[5]); w.w = pk2(e[6], e[7]);
            *(u32x4*)dcur = w; }
          TR_BAR();
          t = tn_;
      }
      asm volatile("s_waitcnt vmcnt(0)" ::: "memory");
      __syncthreads();
#undef TR_ADDR
#undef TR_BAR
    }
    { bf16_t* XB = (bf16_t*)(ws + WS_XB); float* SS = (float*)(ws + WS_SS);
      int row = bid * 8 + wid; f32x4 v[4];
#define XROW(r_) ((r_) < TP ? P.in[0] + (size_t)(r_) * DM : P.in[1] + (size_t)((r_) - TP) * DM)
      if (row < T) { const float* xr = XROW(row);
#pragma unroll
          for (int i = 0; i < 4; ++i) v[i] = *(const f32x4*)(xr + i * 256 + lane * 4); }
      while (row < T) {
          const int nrow = row + G * 8; f32x4 nv[4];
          if (nrow < T) { const float* xr = XROW(nrow);
#pragma unroll
              for (int i = 0; i < 4; ++i) nv[i] = *(const f32x4*)(xr + i * 256 + lane * 4); }
          else {
#pragma unroll
              for (int i = 0; i < 4; ++i) nv[i] = v[i]; }
          float ss = 0.f;
#pragma unroll
          for (int i = 0; i < 4; ++i) { ss += (v[i][0] * v[i][0] + v[i][1] * v[i][1]) + (v[i][2] * v[i][2] + v[i][3] * v[i][3]);
              u32x2 w; w.x = pk2(v[i][0], v[i][1]); w.y = pk2(v[i][2], v[i][3]); *(u32x2*)(XB + (size_t)row * DM + i * 256 + lane * 4) = w; }
#pragma unroll
          for (int o = 32; o >= 1; o >>= 1) ss += __shfl_xor(ss, o);
          if (lane < 16) SS[(size_t)row * 16 + lane] = lane == 0 ? ss : 0.f;
          row = nrow;
#pragma unroll
          for (int i = 0; i < 4; ++i) v[i] = nv[i];
      }
#undef XROW
    }
    { float* R = (float*)(ws + WS_ROPE);
      for (int e = bid * NTHR + tid; e < 8256 * 8; e += G * NTHR) {
          const int pi = e >> 3, i = e & 7; const int pos = pi < 8192 ? pi : 4096 + (pi - 8192);
          const double fr = (i == 0) ? 1.0 : (i == 1) ? 0.1939227432012558 : (i == 2) ? 0.03760603070259094 : (i == 3) ? 0.007292664609849453 : (i == 4) ? 0.0014142135623842478
                          : (i == 5) ? 0.00027424818836152554 : (i == 6) ? 5.3182957344688475e-05 : 1.0313385246263351e-05;
          const float angf = (float)pos * (float)fr;
          float c, s; sincos_d((double)angf, c, s);
          R[(size_t)pi * 16 + i] = c; R[(size_t)pi * 16 + 8 + i] = s;
      } }
    { const size_t gt = (size_t)bid * NTHR + tid, gs = (size_t)G * NTHR;
      for (size_t e = gt; e < (size_t)2 * 32 * 2048; e += gs) {
          const size_t blk = e / 2048, r = e % 2048;
          const f32x4 kv = *(const f32x4*)(P.in[2] + blk * 16384 + 8192 + r * 4), vv = *(const f32x4*)(P.in[3] + blk * 16384 + 8192 + r * 4);
          *(f32x4*)(P.out + O_KWS + blk * 16384 + r * 4) = kv; *(f32x4*)(P.out + O_VWS + blk * 16384 + r * 4) = vv; }
      for (size_t e = gt; e < (size_t)2 * 32 * 57344; e += gs) {
          const size_t blk = e / 57344, r = e % 57344;
          const f32x4 kv = *(const f32x4*)(P.in[4] + blk * 262144 + 32768 + r * 4), vv = *(const f32x4*)(P.in[5] + blk * 262144 + 32768 + r * 4);
          *(f32x4*)(P.out + O_KBS + blk * 262144 + r * 4) = kv; *(f32x4*)(P.out + O_VBS + blk * 262144 + r * 4) = vv; }
    }
}

constexpr int AT_KS = 0, AT_VT = 2 * 9216, AT_BT = 4 * 9216;
struct TileSrc { const unsigned char* k; const unsigned char* v; int f32; int ldb; };

DI void attn_phase(const Params& P, LAS unsigned char* lds, int layer) {
    int tid_ = threadIdx.x; asm volatile("" : "+v"(tid_));
    const int tid = tid_, lane = tid & 63, wid = __builtin_amdgcn_readfirstlane(tid >> 6), G = gridDim.x;
    unsigned char* ws = P.ws;
    const bf16_t* QA = (const bf16_t*)(ws + WS_REG + REG_QA); const bf16_t* QB = (const bf16_t*)(ws + WS_REG + REG_QB);
    const bf16_t* KA = (const bf16_t*)(ws + WS_KA); const bf16_t* VA = (const bf16_t*)(ws + WS_VA);
    const bf16_t* KBp = (const bf16_t*)(ws + WS_KB); const bf16_t* VBp = (const bf16_t*)(ws + WS_VB);
    bf16_t* YA = (bf16_t*)(ws + WS_XB); bf16_t* YB = YA + (size_t)T * 512;
    const float* ckw = P.in[2] + (size_t)layer * 32 * 128 * 128; const float* cvw = P.in[3] + (size_t)layer * 32 * 128 * 128;
    const float* ckb = P.in[4] + (size_t)layer * 32 * 512 * 512; const float* cvb = P.in[5] + (size_t)layer * 32 * 512 * 512;
    const float* sinks = P.in[12] + layer * 8; const float* relb = P.in[13] + (size_t)layer * 8 * 257;
    LAS float* bt = (LAS float*)(lds + AT_BT);
    const int key = tid >> 3, dp = tid & 7;
    const int ql = lane & 31, h = lane >> 5;

    for (int it = 0; it < 10; ++it) {
        const int c = blockIdx.x;
        int mixB, smp, b = 0, hk, c0 = 0, j0, j1, ncache = 0;
        if (it < 4) { const int bh = it * 8 + (c & 7); mixB = 1; smp = 0; b = bh >> 3; hk = bh & 7; c0 = 4 * (c >> 3); j0 = c0 - 8 < 0 ? 0 : c0 - 8; j1 = c0 + 3; }
        else if (it == 4) { mixB = 1; smp = 1; b = c >> 3; hk = c & 7; c0 = 8; j0 = 0; j1 = 8; ncache = 8; }
        else if (it < 9) { mixB = 0; smp = 0; b = it - 5; hk = c & 1; c0 = ((c & 7) >> 1) * 32 + (c >> 3); j0 = c0 - 2 < 0 ? 0 : c0 - 2; j1 = c0; }
        else { if (c >= 64) break; mixB = 0; smp = 1; b = c >> 1; hk = c & 1; c0 = 2; j0 = 0; j1 = 2; ncache = 2; }
        const int ldkv = mixB ? 512 : 128;
        const bf16_t* Kbuf = mixB ? KBp : KA; const bf16_t* Vbuf = mixB ? VBp : VA;
        const float* ck = mixB ? ckb : ckw; const float* cv = mixB ? cvb : cvw;
        const int clen = mixB ? 512 : 128, nh = mixB ? 8 : 2;
        int cw, hq, wlo, whi; long qrow0;
        if (!mixB) { cw = c0; hq = 4 * hk + (wid >> 1); wlo = j0; whi = j1; }
        else if (!smp) { cw = c0 + (wid >> 1); hq = hk; wlo = cw - 8 < 0 ? 0 : cw - 8; whi = cw; }
        else { cw = 8; hq = hk; wlo = wid < 2 ? 0 : 1; whi = wid < 2 ? 8 : 0; }
        qrow0 = (smp ? (long)TP + b * 64 : (long)b * 8192 + (long)cw * 64) + 32 * (wid & 1);
        const bool wave_on = wlo <= whi;
        const bf16_t* Qp = (mixB ? QB : QA) + (size_t)(qrow0 + ql) * 512 + hq * 64 + 8 * h;
        bf16x8 qf[4];
        if (wave_on) {
#pragma unroll
            for (int s = 0; s < 4; ++s) qf[s] = *(const bf16x8*)(Qp + 16 * s);
        } else {
#pragma unroll
            for (int s = 0; s < 4; ++s) qf[s] = (bf16x8){0, 0, 0, 0, 0, 0, 0, 0};
        }
        if (mixB) { for (int i = tid; i < 257; i += NTHR) bt[i] = relb[hk * 257 + i] * LOG2E; }
        const float sinkv = mixB ? -1e30f : sinks[hq] * LOG2E;
        float m_run = sinkv, l_run = 0.f;
        f32x16 O0, O1;
#pragma unroll
        for (int r = 0; r < 16; ++r) { O0[r] = 0.f; O1[r] = 0.f; }

        auto tsrc = [&](int j) -> TileSrc { TileSrc s;
            if (!smp) { const size_t row = (size_t)b * 8192 + (size_t)j * 64; s.k = (const unsigned char*)(Kbuf + row * ldkv + hk * 64); s.v = (const unsigned char*)(Vbuf + row * ldkv + hk * 64); s.f32 = 0; s.ldb = ldkv * 2; }
            else if (j < ncache) { const size_t e = (((size_t)b * clen + (size_t)j * 64) * nh + hk) * 64; s.k = (const unsigned char*)(ck + e); s.v = (const unsigned char*)(cv + e); s.f32 = 1; s.ldb = nh * 64 * 4; }
            else { const size_t row = (size_t)TP + (size_t)b * 64; s.k = (const unsigned char*)(Kbuf + row * ldkv + hk * 64); s.v = (const unsigned char*)(Vbuf + row * ldkv + hk * 64); s.f32 = 0; s.ldb = ldkv * 2; }
            return s; };
        u32x4 rg[4]; int rg_f32 = 0;
#define AT_LOAD(j, rg, rg_f32) do { const TileSrc _s = tsrc(j); rg_f32 = _s.f32; \
            if (_s.f32) { const unsigned char* kp = _s.k + (size_t)key * _s.ldb + dp * 32; const unsigned char* vp = _s.v + (size_t)key * _s.ldb + dp * 32; \
                rg[0] = *(const u32x4*)kp; rg[1] = *(const u32x4*)(kp + 16); rg[2] = *(const u32x4*)vp; rg[3] = *(const u32x4*)(vp + 16); } \
            else { rg[0] = *(const u32x4*)(_s.k + (size_t)key * _s.ldb + dp * 16); rg[2] = *(const u32x4*)(_s.v + (size_t)key * _s.ldb + dp * 16); \
                   rg[1] = (u32x4){0u, 0u, 0u, 0u}; rg[3] = (u32x4){0u, 0u, 0u, 0u}; } } while (0)
#define AT_WRITE(buf, rg, rg_f32) do { u32x4 kk, vv; \
            if (rg_f32) { kk.x = pk2(__uint_as_float(rg[0].x), __uint_as_float(rg[0].y)); kk.y = pk2(__uint_as_float(rg[0].z), __uint_as_float(rg[0].w)); \
                          kk.z = pk2(__uint_as_float(rg[1].x), __uint_as_float(rg[1].y)); kk.w = pk2(__uint_as_float(rg[1].z), __uint_as_float(rg[1].w)); \
                          vv.x = pk2(__uint_as_float(rg[2].x), __uint_as_float(rg[2].y)); vv.y = pk2(__uint_as_float(rg[2].z), __uint_as_float(rg[2].w)); \
                          vv.z = pk2(__uint_as_float(rg[3].x), __uint_as_float(rg[3].y)); vv.w = pk2(__uint_as_float(rg[3].z), __uint_as_float(rg[3].w)); } \
            else { kk = rg[0]; vv = rg[2]; } \
            *(LAS u32x4*)(lds + AT_KS + (buf) * 9216 + key * 144 + dp * 16) = kk; \
            LAS bf16_t* vt = (LAS bf16_t*)(lds + AT_VT + (buf) * 9216) + (8 * dp) * 72 + ((((key >> 2) ^ dp) << 2) | (key & 3)); \
            vt[0 * 72] = (bf16_t)(vv.x & 0xffffu); vt[1 * 72] = (bf16_t)(vv.x >> 16); vt[2 * 72] = (bf16_t)(vv.y & 0xffffu); vt[3 * 72] = (bf16_t)(vv.y >> 16); \
            vt[4 * 72] = (bf16_t)(vv.z & 0xffffu); vt[5 * 72] = (bf16_t)(vv.z >> 16); vt[6 * 72] = (bf16_t)(vv.w & 0xffffu); vt[7 * 72] = (bf16_t)(vv.w >> 16); } while (0)

        AT_LOAD(j0, rg, rg_f32); AT_WRITE(0, rg, rg_f32);
        __builtin_amdgcn_s_waitcnt(0);
#pragma unroll
        for (int s = 0; s < 4; ++s) asm volatile("" : "+v"(qf[s]));
        if (j0 < j1) AT_LOAD(j0 + 1, rg, rg_f32);
        asm volatile("s_waitcnt lgkmcnt(0)" ::: "memory"); __builtin_amdgcn_s_barrier(); asm volatile("" ::: "memory");
        for (int j = j0; j <= j1; ++j) {
            const int buf = (j - j0) & 1;
            if (wave_on && j >= wlo && j <= whi) {
                const LAS unsigned char* Ks = lds + AT_KS + buf * 9216; const LAS unsigned char* Vt = lds + AT_VT + buf * 9216;
                f32x16 S0, S1; bf16x8 kf0[4], kf1[4];
#pragma unroll
                for (int r = 0; r < 16; ++r) { S0[r] = 0.f; S1[r] = 0.f; }
#pragma unroll
                for (int s = 0; s < 4; ++s) { kf0[s] = *(const LAS bf16x8*)(Ks + ql * 144 + 32 * s + 16 * h); kf1[s] = *(const LAS bf16x8*)(Ks + (32 + ql) * 144 + 32 * s + 16 * h); }
                __builtin_amdgcn_sched_barrier(0);
#pragma unroll
                for (int s = 0; s < 4; ++s) {
                    S0 = __builtin_amdgcn_mfma_f32_32x32x16_bf16(kf0[s], qf[s], S0, 0, 0, 0);
                    S1 = __builtin_amdgcn_mfma_f32_32x32x16_bf16(kf1[s], qf[s], S1, 0, 0, 0);
                }
                bf16x8 vf0[4], vf1[4];
#pragma unroll
                for (int kb = 0; kb < 2; ++kb)
#pragma unroll
                    for (int s = 0; s < 2; ++s) {
                        const int kg = 8 * kb + 4 * s + h;
                        const int ko = (kg ^ (ql >> 3)) << 3, ko2 = ((kg + 2) ^ (ql >> 3)) << 3;
                        { const s16x4 lo = *(const LAS s16x4*)(Vt + ql * 144 + ko), hi = *(const LAS s16x4*)(Vt + ql * 144 + ko2);
                          vf0[kb * 2 + s] = __builtin_shufflevector(lo, hi, 0, 1, 2, 3, 4, 5, 6, 7); }
                        { const s16x4 lo = *(const LAS s16x4*)(Vt + (32 + ql) * 144 + (ko ^ 32)), hi = *(const LAS s16x4*)(Vt + (32 + ql) * 144 + (ko2 ^ 32));
                          vf1[kb * 2 + s] = __builtin_shufflevector(lo, hi, 0, 1, 2, 3, 4, 5, 6, 7); }
                    }
                __builtin_amdgcn_sched_barrier(0);
                if (mixB) {
                    const int rel0 = 64 * (j - cw);
                    if (rel0 <= -192) { const float bb = bt[0];
#pragma unroll
                        for (int r = 0; r < 16; ++r) { S0[r] += bb; S1[r] += bb; }
                    } else if (rel0 >= -64) {
                        const LAS float* bp = bt + (rel0 - (32 * (wid & 1) + ql) + 4 * h + 128);
#pragma unroll
                        for (int r = 0; r < 16; ++r) { const int kk = (r & 3) + 8 * (r >> 2); S0[r] += bp[kk]; S1[r] += bp[32 + kk]; }
                    } else {
                        const int base = rel0 - (32 * (wid & 1) + ql) + 4 * h + 128;
#pragma unroll
                        for (int r = 0; r < 16; ++r) { const int kk = (r & 3) + 8 * (r >> 2);
                            int i0 = base + kk, i1 = base + 32 + kk; i0 = i0 < 0 ? 0 : (i0 > 256 ? 256 : i0); i1 = i1 < 0 ? 0 : (i1 > 256 ? 256 : i1);
                            S0[r] += bt[i0]; S1[r] += bt[i1]; }
                    }
                }
                float mx = S0[0];
#pragma unroll
                for (int r = 1; r < 16; ++r) mx = fmaxf(mx, S0[r]);
#pragma unroll
                for (int r = 0; r < 16; ++r) mx = fmaxf(mx, S1[r]);
                mx = fmaxf(mx, __shfl_xor(mx, 32));
                const float mn = fmaxf(m_run, mx); const float alpha = fast_exp2(m_run - mn); m_run = mn;
                float ps = 0.f;
#pragma unroll
                for (int r = 0; r < 16; ++r) { S0[r] = fast_exp2(S0[r] - mn); S1[r] = fast_exp2(S1[r] - mn); ps += S0[r] + S1[r]; }
                l_run = l_run * alpha + ps;
#pragma unroll
                for (int r = 0; r < 16; ++r) { O0[r] *= alpha; O1[r] *= alpha; }
#pragma unroll
                for (int kb = 0; kb < 2; ++kb)
#pragma unroll
                    for (int s = 0; s < 2; ++s) {
                        u32x4 pw;
#pragma unroll
                        for (int q = 0; q < 4; ++q) pw[q] = kb == 0 ? pk2(S0[8 * s + 2 * q], S0[8 * s + 2 * q + 1]) : pk2(S1[8 * s + 2 * q], S1[8 * s + 2 * q + 1]);
                        const bf16x8 pf = __builtin_bit_cast(bf16x8, pw);
                        O0 = __builtin_amdgcn_mfma_f32_32x32x16_bf16(vf0[kb * 2 + s], pf, O0, 0, 0, 0);
                        O1 = __builtin_amdgcn_mfma_f32_32x32x16_bf16(vf1[kb * 2 + s], pf, O1, 0, 0, 0);
                    }
            }
            if (j < j1) { AT_WRITE(buf ^ 1, rg, rg_f32); if (j + 2 <= j1) AT_LOAD(j + 2, rg, rg_f32); }
            asm volatile("s_waitcnt lgkmcnt(0)" ::: "memory"); __builtin_amdgcn_s_barrier(); asm volatile("" ::: "memory");
        }
#undef AT_LOAD
#undef AT_WRITE
        if (wave_on) {
            float lt = l_run + __shfl_xor(l_run, 32);
            if (!mixB) lt += fast_exp2(sinkv - m_run);
            const float inv = 1.0f / lt;
            bf16_t* yp = (mixB ? YB : YA) + (size_t)(qrow0 + ql) * 512 + hq * 64 + 4 * h;
#pragma unroll
            for (int g4 = 0; g4 < 4; ++g4) {
                u32x2 w0, w1;
                w0.x = pk2(O0[4 * g4] * inv, O0[4 * g4 + 1] * inv); w0.y = pk2(O0[4 * g4 + 2] * inv, O0[4 * g4 + 3] * inv);
                w1.x = pk2(O1[4 * g4] * inv, O1[4 * g4 + 1] * inv); w1.y = pk2(O1[4 * g4 + 2] * inv, O1[4 * g4 + 3] * inv);
                *(u32x2*)(yp + 8 * g4) = w0; *(u32x2*)(yp + 32 + 8 * g4) = w1;
            }
        }
    }
}

DI void final_phase(const Params& P) {
    const int tid = threadIdx.x, lane = tid & 63, wid = tid >> 6, G = gridDim.x;
    const float* SS = (const float*)(P.ws + WS_SS); const float* g = P.in[20];
    f32x4 gv[4];
#pragma unroll
    for (int i = 0; i < 4; ++i) gv[i] = *(const f32x4*)(g + i * 256 + lane * 4);
    int row = blockIdx.x * 8 + wid; f32x4 v[4]; f32x4 sv = {0.f, 0.f, 0.f, 0.f};
    if (row < T) { const float* xr = P.out + O_Y + (size_t)row * DM; sv = *(const f32x4*)(SS + (size_t)row * 16 + 4 * (lane & 3));
#pragma unroll
        for (int i = 0; i < 4; ++i) v[i] = *(const f32x4*)(xr + i * 256 + lane * 4); }
    while (row < T) {
        const int nrow = row + G * 8; f32x4 nv[4]; f32x4 nsv = sv;
        if (nrow < T) { const float* xr = P.out + O_Y + (size_t)nrow * DM; nsv = *(const f32x4*)(SS + (size_t)nrow * 16 + 4 * (lane & 3));
#pragma unroll
            for (int i = 0; i < 4; ++i) nv[i] = *(const f32x4*)(xr + i * 256 + lane * 4); }
        else {
#pragma unroll
            for (int i = 0; i < 4; ++i) nv[i] = v[i]; }
        float t = (sv[0] + sv[1]) + (sv[2] + sv[3]); t += __shfl_xor(t, 1); t += __shfl_xor(t, 2);
        const float rs = rsqrtf(t * (1.0f / 1024.0f) + EPS);
        float* xo = P.out + O_Y + (size_t)row * DM;
#pragma unroll
        for (int i = 0; i < 4; ++i) *(f32x4*)(xo + i * 256 + lane * 4) = v[i] * rs * gv[i];
        row = nrow; sv = nsv;
#pragma unroll
        for (int i = 0; i < 4; ++i) v[i] = nv[i];
    }
}

#define XB_TMO      128
#define XB_XCNT(j)  (256  + 64 * (j))
#define XB_XSUB(j)  (1280 + 64 * (j))
#define XB_XGEN(j)  (2304 + 64 * (j))
#define XB_TOP      3328
#define XB_TOPGEN   3392
#define XCD_BAR_WORDS 3456
#define XB_SPIN_CAP (1u << 22)
DI unsigned xb_ld(unsigned* p) { return __hip_atomic_load(p, __ATOMIC_RELAXED, __HIP_MEMORY_SCOPE_AGENT); }
DI unsigned xb_add(unsigned* p, unsigned v) { return __hip_atomic_fetch_add(p, v, __ATOMIC_RELAXED, __HIP_MEMORY_SCOPE_AGENT); }
DI unsigned xb_xcc_id() { return (unsigned)__builtin_amdgcn_s_getreg((3 << 11) | 20) & 0xFu; }
#define XB_SPIN(cond, bar) do { unsigned _sp = 0; while (cond) { __builtin_amdgcn_s_sleep(1); \
    if ((++_sp & 255u) == 0u) { if (xb_ld(&(bar)[XB_TMO])) break; if (_sp > XB_SPIN_CAP) { atomicAdd(&(bar)[XB_TMO], 1u); break; } } } } while (0)
struct XcdBarrier { unsigned* bar; unsigned x; volatile LAS unsigned* st; };
DI XcdBarrier xcd_barrier_post(unsigned* bar, volatile LAS unsigned* st) {
    XcdBarrier b; b.bar = bar; b.x = xb_xcc_id(); b.st = st;
    if (threadIdx.x == 0) (void)xb_add(&bar[XB_XCNT(b.x)], 1u);
    return b;
}
DI void xcd_barrier_complete(unsigned* bar, unsigned x, unsigned& nloc, unsigned& nx) {
    const unsigned G = gridDim.x;
    unsigned sum, cnt, mine, sp = 0u;
    for (;;) {
        sum = 0u; cnt = 0u; mine = 0u;
#pragma unroll
        for (unsigned j = 0; j < 16; ++j) { const unsigned c = xb_ld(&bar[XB_XCNT(j)]); sum += c; cnt += (c > 0u) ? 1u : 0u; mine = (j == x) ? c : mine; }
        if (sum == G) break;
        __builtin_amdgcn_s_sleep(1);
        if ((++sp & 255u) == 0u) { if (xb_ld(&bar[XB_TMO])) break; if (sp > XB_SPIN_CAP) { atomicAdd(&bar[XB_TMO], 1u); break; } }
    }
    nloc = mine > 0u ? mine : 1u; nx = cnt > 0u ? cnt : 1u;
}
DI void xcd_barrier(const XcdBarrier& b) {
    asm volatile("s_waitcnt vmcnt(0)" ::: "memory");
    __syncthreads();
    if (threadIdx.x == 0) {
        unsigned* bar = b.bar;
        __builtin_amdgcn_s_waitcnt(0);
        unsigned nloc = b.st[0], nx = b.st[1];
        if (nloc == 0u) { xcd_barrier_complete(bar, b.x, nloc, nx); b.st[0] = nloc; b.st[1] = nx; }
        const unsigned old = xb_add(&bar[XB_XSUB(b.x)], 1u);
        const unsigned gen = old / nloc;
        if (old + 1u == (gen + 1u) * nloc) {
            __builtin_amdgcn_fence(__ATOMIC_RELEASE, "agent");
            asm volatile("s_waitcnt vmcnt(0)" ::: "memory");
            const unsigned og = xb_add(&bar[XB_TOP], 1u);
            const unsigned tg = og / nx;
            if (og + 1u == (tg + 1u) * nx) xb_add(&bar[XB_TOPGEN], 1u);
            else XB_SPIN(xb_ld(&bar[XB_TOPGEN]) == tg, bar);
            __builtin_amdgcn_fence(__ATOMIC_ACQUIRE, "agent");
            xb_add(&bar[XB_XGEN(b.x)], 1u);
            asm volatile("s_waitcnt vmcnt(0)" ::: "memory");
        } else {
            XB_SPIN(xb_ld(&bar[XB_XGEN(b.x)]) == gen, bar);
            __builtin_amdgcn_fence(__ATOMIC_ACQUIRE, "agent");
            asm volatile("s_waitcnt vmcnt(0)" ::: "memory");
        }
    }
    __syncthreads();
}

__global__ void __launch_bounds__(NTHR) fwd_megakernel(Params P, int ph_lo, int ph_hi) {
    extern __shared__ __attribute__((aligned(16))) unsigned char lds_raw[];
    LAS unsigned char* lds = (LAS unsigned char*)lds_raw;
    cg::grid_group grid = cg::this_grid();
    unsigned char* ws = P.ws; const int G = gridDim.x, bid = blockIdx.x;
    bf16_t* XB = (bf16_t*)(ws + WS_XB); float* SS = (float*)(ws + WS_SS); float* X = P.out + O_Y;
    bf16_t* HID = (bf16_t*)(ws + WS_REG); bf16_t* MB = (bf16_t*)(ws + WS_REG + REG_MB); bf16_t* GATES = (bf16_t*)(ws + WS_REG + REG_GATES);
    volatile LAS unsigned* xst = (volatile LAS unsigned*)(lds + pg8::STAGE_BYTES);
    if (threadIdx.x < 4) xst[threadIdx.x] = 0u;
    __syncthreads();
    const XcdBarrier xbar = xcd_barrier_post((unsigned*)(ws + WS_BAR), xst);
    float* SLAB = (float*)(ws + WS_SLAB); unsigned* CNT = (unsigned*)(ws + WS_CNT);
    int ph = 0;
#define SEAM() do { ++ph; if (ph > ph_lo && ph < ph_hi) { if (ph == 1) grid.sync(); else xcd_barrier(xbar); } } while (0)
#define RUN (ph >= ph_lo && ph < ph_hi)
    if (RUN) prologue(P, lds);
    SEAM();
    for (int l = 0; l < NL; ++l) {
        const unsigned char* wl = ws + WS_W + (size_t)l * WL_B;
        for (int f = 0; f < 2; ++f) {
            if (f == 1) {
                if (RUN) { pg8::Gemm g{XB, (const bf16_t*)(wl + WO3), T, DIN, DM}; pg8::StaticOrder<T, DIN, DM, false, 1> S; S.init(bid, SLAB, CNT + ph * 256);
                    EpiProj E{ws, P.in[11] + l * 2048, P.out, l};
                    pg8::gemm_phase(lds, g, S, E); }
                SEAM();
                if (RUN) {
                    if (bid < 8) { pg8::Gemm g{XB, (const bf16_t*)(wl + WO3), T, DIN, DM}; pg8::StaticOrder<T, DIN, DM, false, 2> S; S.init(bid, SLAB, CNT + ph * 256);
                        EpiProj E{ws, P.in[11] + l * 2048, P.out, l};
                        pg8::gemm_phase(lds, g, S, E); }
                    attn_phase(P, lds, l); }
                SEAM();
                if (RUN) { pg8::Gemm g{XB  , (const bf16_t*)(wl + WO4), 2 * T, 2048, 512}; pg8::MergeOrder S; S.so.init(bid, nullptr, nullptr); S.slab = nullptr; S.cnt = nullptr;
                    EpiMerge E{GATES, MB}; pg8::gemm_phase(lds, g, S, E); }
                if (RUN) small_merge(lds, XB + (size_t)TP * 512, XB + (size_t)T * 512 + (size_t)TP * 512, (const bf16_t*)(wl + WO4), GATES + (size_t)TP * 2048, MB + (size_t)TP * DM);
                SEAM();
                if (RUN) { pg8::Gemm g{MB, (const bf16_t*)(wl + WO5), T, DM, DM}; pg8::StaticOrder<TP, DM, DM, false> S; S.init(bid, SLAB, CNT + ph * 256);
                    EpiResid E{X, X + (size_t)TP * DM, X, XB, SS, 1.0f, true}; pg8::gemm_phase(lds, g, S, E); }
                if (RUN) small_resid(lds, MB + (size_t)TP * DM, (const bf16_t*)(wl + WO5), DM, X + (size_t)TP * DM, X + (size_t)TP * DM, XB + (size_t)TP * DM, SS + (size_t)TP * 16, 1.0f);
                SEAM();
            }
            if (RUN) { pg8::Gemm g{XB, (const bf16_t*)(wl + (f ? WO6 : WO1)), T, 2 * DFF, DM}; pg8::StaticOrder<T, 2 * DFF, DM, true> S; S.init(bid, SLAB, CNT + ph * 256);
                EpiSwiglu E{HID, SS}; pg8::gemm_phase(lds, g, S, E); }
            SEAM();
            if (RUN) { pg8::Gemm g{HID, (const bf16_t*)(wl + (f ? WO7 : WO2)), T, DM, DFF}; pg8::StaticOrder<TP, DM, DFF, false> S; S.init(bid, SLAB, CNT + ph * 256);
                const bool first = (l == 0 && f == 0);
                const bool wxb = !(l == NL - 1 && f == 1);
                EpiResid E{first ? P.in[0] : X, first ? P.in[1] : X + (size_t)TP * DM, X, XB, SS, 0.5f, wxb}; pg8::gemm_phase(lds, g, S, E);
                small_resid(lds, HID + (size_t)TP * DFF, (const bf16_t*)(wl + (f ? WO7 : WO2)), DFF, first ? P.in[1] : X + (size_t)TP * DM, X + (size_t)TP * DM, XB + (size_t)TP * DM, SS + (size_t)TP * 16, 0.5f, wxb); }
            SEAM();
        }
    }
    if (RUN) final_phase(P);
#undef SEAM
#undef RUN
}

constexpr int LDS_BYTES = BG_OFF + 8192;
constexpr int N_PHASES = 1 + NL * 8 + 1;
constexpr int GRID_HOST = pg8::GRID;

extern "C" void kernel_launch(void* const* d_in, const int* in_sizes, int n_in, void* d_out, int out_size, void* d_ws, size_t ws_size, hipStream_t stream) {
    static int grid = 0;
    if (grid == 0) {
        if (n_in != 21 || (size_t)out_size != O_END || ws_size < WS_END) { fprintf(stderr, "kernel_launch: unexpected shapes: n_in %d out %d ws %zu (need %zu)\n", n_in, out_size, ws_size, (size_t)WS_END); grid = -1; return; }
        int dev = 0, cus = 0, per_cu = 0;
        hipGetDevice(&dev); hipDeviceGetAttribute(&cus, hipDeviceAttributeMultiprocessorCount, dev);
        if (hipFuncSetAttribute((const void*)fwd_megakernel, hipFuncAttributeMaxDynamicSharedMemorySize, LDS_BYTES) != hipSuccess) { fprintf(stderr, "kernel_launch: hipFuncSetAttribute failed\n"); grid = -1; return; }
        if (hipOccupancyMaxActiveBlocksPerMultiprocessor(&per_cu, (const void*)fwd_megakernel, NTHR, LDS_BYTES) != hipSuccess || per_cu < 1) per_cu = 1;
        (void)hipGetLastError();
        if (cus * per_cu < GRID_HOST) fprintf(stderr, "kernel_launch: device admits %d workgroups, kernel needs %d\n", cus * per_cu, GRID_HOST);
        grid = GRID_HOST;
        fprintf(stderr, "kernel_launch: grid %d (cus %d x %d)\n", grid, cus, per_cu);
    }
    if (grid < 0) return;
    if (hipMemsetAsync((char*)d_ws + WS_BAR, 0, 16384 + 18 * 256 * 4, stream) != hipSuccess) { fprintf(stderr, "kernel_launch: memset failed\n"); return; }
    Params p{};
    for (int i = 0; i < 21; ++i) p.in[i] = (const float*)d_in[i];
    p.out = (float*)d_out; p.ws = (unsigned char*)d_ws;
    int lo = 0, hi = N_PHASES;
    void* args[] = {&p, &lo, &hi};
    hipError_t e = hipLaunchCooperativeKernel((const void*)fwd_megakernel, dim3(grid), dim3(NTHR), args, LDS_BYTES, stream);
    if (e != hipSuccess) fprintf(stderr, "kernel_launch: cooperative launch failed: %s (grid %d)\n", hipGetErrorString(e), grid);
}
```

```cpp
#include <hip/hip_runtime.h>
#include <hip/hip_cooperative_groups.h>
#include <cstdio>
namespace cg = cooperative_groups;

#define LAS __attribute__((address_space(3)))
#define DI __device__ __forceinline__
typedef unsigned short bf16_t;
typedef short bf16x8 __attribute__((ext_vector_type(8)));
typedef short s16x4 __attribute__((ext_vector_type(4)));
typedef float f32x2 __attribute__((ext_vector_type(2)));
typedef float f32x4 __attribute__((ext_vector_type(4)));
typedef float f32x16 __attribute__((ext_vector_type(16)));
typedef unsigned u32x2 __attribute__((ext_vector_type(2)));
typedef unsigned u32x4 __attribute__((ext_vector_type(4)));
typedef __bf16 hbf2 __attribute__((ext_vector_type(2)));

constexpr int TP = 32768, TS = 2048, T = TP + TS, DM = 1024, DFF = 2816, DIN = 4352, NL = 2;
constexpr int NTHR = 512;
constexpr float EPS = 1e-5f;
constexpr float LOG2E = 1.4426950408889634f;
constexpr float QSCALE = 0.125f * LOG2E;

constexpr size_t W1_B = (size_t)2 * DFF * DM * 2, W2_B = (size_t)DM * DFF * 2, W3_B = (size_t)DIN * DM * 2, W4_B = (size_t)2048 * 512 * 2, W5_B = (size_t)DM * DM * 2;
constexpr size_t WO1 = 0, WO2 = WO1 + W1_B, WO3 = WO2 + W2_B, WO4 = WO3 + W3_B, WO5 = WO4 + W4_B, WO6 = WO5 + W5_B, WO7 = WO6 + W1_B, WL_B = WO7 + W2_B;
constexpr size_t WS_W = 0;
constexpr size_t WS_XB = WS_W + NL * WL_B;
constexpr size_t WS_REG = WS_XB + (size_t)T * DM * 2;
constexpr size_t REG_QA = 0, REG_QB = (size_t)T * 512 * 2, REG_MB = 0, REG_GATES = (size_t)T * DM * 2;
constexpr size_t REG_B = (size_t)T * DM * 2 + (size_t)T * 2048 * 2;
constexpr size_t WS_KA = WS_REG + REG_B, WS_VA = WS_KA + (size_t)T * 128 * 2, WS_KB = WS_VA + (size_t)T * 128 * 2, WS_VB = WS_KB + (size_t)T * 512 * 2;
constexpr size_t WS_SS = WS_VB + (size_t)T * 512 * 2;
constexpr size_t WS_ROPE = WS_SS + (size_t)T * 16 * 4;
constexpr size_t WS_BAR = WS_ROPE + (size_t)8256 * 16 * 4;
constexpr size_t WS_CNT = WS_BAR + 16384;
constexpr size_t WS_SLAB = WS_CNT + 18 * 256 * 4;
constexpr size_t WS_END = WS_SLAB + 4096;
static_assert((size_t)T * DFF * 2 <= REG_B, "hidden fits the region");

constexpr size_t O_Y = 0, O_KWP = (size_t)T * DM, O_VWP = O_KWP + 131072, O_KBP = O_VWP + 131072, O_VBP = O_KBP + 2097152,
                 O_KWS = O_VBP + 2097152, O_VWS = O_KWS + 1048576, O_KBS = O_VWS + 1048576, O_VBS = O_KBS + 16777216, O_END = O_VBS + 16777216;

struct Params { const float* in[21]; float* out; unsigned char* ws; };

DI unsigned pk2(float lo, float hi) { f32x2 v = {lo, hi}; hbf2 r = __builtin_convertvector(v, hbf2); return __builtin_bit_cast(unsigned, r); }
DI float fast_exp2(float x) { return __builtin_amdgcn_exp2f(x); }
DI float fast_rcp(float x) { return __builtin_amdgcn_rcpf(x); }

constexpr int BG_OFF = 8 * 128 * 64 * 2 + 64 + 12 * 1024;
constexpr int RS_NTAB = 12, RS_OFF = 8 * 128 * 64 * 2 + 64;
DI float row_rs_g(const float* SS, int row) {
    const f32x4* p = (const f32x4*)(SS + (size_t)row * 16);
    const f32x4 a = p[0], b = p[1], c = p[2], d = p[3];
    const float s = ((a[0] + a[1]) + (a[2] + a[3])) + ((b[0] + b[1]) + (b[2] + b[3])) + ((c[0] + c[1]) + (c[2] + c[3])) + ((d[0] + d[1]) + (d[2] + d[3]));
    return rsqrtf(s * (1.0f / 1024.0f) + 1e-5f);
}
namespace pg8 {
constexpr int BM = 256, BK = 64, HALF = 128, HTB = HALF * BK * 2, STAGE_BYTES = 8 * HTB, NXCD = 8, WGM = 8;
DI int lds_byte(int r, int c) { const int st = (r >> 4) * 2 + (c >> 5), rr = r & 15, cc = c & 31, ob = rr * 64 + cc * 2; return st * 1024 + (ob ^ (((ob >> 9) & 1) << 5)); }
DI void stage_rc(int b, int& R, int& C) { const int st = b / 1024, sb = b % 1024, swz = sb ^ (((sb >> 9) & 1) << 5); R = (st >> 1) * 16 + swz / 64; C = (st & 1) * 32 + (swz % 64) / 2; }
DI int perm32(int rho) { const int n = rho >> 4, i = rho & 15; return 8 * (i >> 2) + 4 * n + (i & 3); }
struct Unit { int pm, pn, kt0, nkt, part, tt, rk; };
struct Gemm { const bf16_t* A; const bf16_t* Bt; int M, N, K; };
constexpr int MAXP = 6;
constexpr int GRID = 256;
template <int M_, int N_, int K_, bool SPLIT, int TAIL = 0>
struct StaticOrder {
    static constexpr int nM = M_ / BM, nN = N_ / BM, nwg = nM * nN, G = GRID, nt = K_ / BK, nfull = nwg / G, rem = nwg % G;
    static constexpr int pmax = (rem > 0 && SPLIT) ? (G / rem < MAXP ? G / rem : MAXP) : 1;
    static constexpr int nparts = pmax < 2 ? 1 : (pmax > nt / 4 ? (nt / 4 < 2 ? 1 : nt / 4) : pmax);
    static constexpr int nrm = TAIL == 0 ? nwg : nfull * G;
    int c; float* slab; unsigned* cnt;
    DI void init(int c_, float* slab_, unsigned* cnt_) { c = c_; slab = slab_; cnt = cnt_; }
    static DI void decode(int L, Unit& u) {
        int wgid = L;
        if (L < nrm) { constexpr int q = nrm / NXCD, r = nrm % NXCD; const int xcd = wgid % NXCD, off = wgid / NXCD; wgid = (xcd < r ? xcd * (q + 1) : r * (q + 1) + (xcd - r) * q) + off; }
        constexpr int nig = WGM * nN; const int gid = wgid / nig, fm = gid * WGM, gsz = (nM - fm) < WGM ? (nM - fm) : WGM;
        u.pm = fm + ((wgid % nig) % gsz); u.pn = (wgid % nig) / gsz;
    }
    DI bool next(int i, Unit& u) const {
        u.kt0 = 0; u.nkt = nt; u.part = -1; u.tt = 0; u.rk = 0;
        if (TAIL == 2) { if (i > 0 || c >= rem) return false; decode(nfull * G + c, u); return true; }
        if (i < nfull) { decode(i * G + c, u); return true; }
        if (TAIL == 1 || i > nfull) return false;
        if (nparts == 1) { if (c >= rem) return false; decode(nfull * G + c, u); return true; }
        if (c >= rem * nparts) return false;
        constexpr int remd = rem > 0 ? rem : 1, pairs = nt / 2, base = pairs / nparts, extra = pairs % nparts;
        const int tt = c % remd, part = c / remd;
        decode(nfull * G + tt, u); u.tt = tt; u.part = part;
        u.kt0 = 2 * (part * base + (part < extra ? part : extra)); u.nkt = 2 * (base + (part < extra ? 1 : 0));
        return true;
    }
};
struct MergeOrder {
    StaticOrder<TP, DM, 512, false> so; static constexpr int nparts = 1; float* slab; unsigned* cnt;
    DI bool next(int i, Unit& u) const { Unit p; if (!so.next(i >> 1, p)) return false; const int s = i & 1; u = p; u.pm = s * (T / BM) + p.pm; u.pn = s * 4 + p.pn; return true; }
};

template <class Epi, class Sched>
DI void gemm_phase(LAS unsigned char* lds, const Gemm g, const Sched& S, const Epi& E) {
    int tid_ = threadIdx.x; asm volatile("" : "+v"(tid_));
    const int tid = tid_, wid = __builtin_amdgcn_readfirstlane(tid >> 6), lane = tid & 63, wr = wid >> 2, wc = wid & 3, fr = lane & 15, fq = lane >> 4;
    const int K = g.K;
    unsigned voffA[2], voffB[2];
#pragma unroll
    for (int i = 0; i < 2; ++i) { int R, C; stage_rc(tid * 16 + i * 8192, R, C); const int Rb = Epi::PERM ? ((R & ~31) + perm32(R & 31)) : R;
        voffA[i] = (unsigned)(R * K + C) * 2u; voffB[i] = (unsigned)(Rb * K + C) * 2u; }
    const size_t kstep = (size_t)(BK * 2);
    const size_t hstep = (size_t)HALF * K * 2;
    const size_t tstep = 2 * hstep;
    const unsigned ldsw = (unsigned)wid * 1024u;
    const int aoff = lds_byte(wr * 64 + fr, fq * 8), boff = lds_byte(wc * 32 + fr, fq * 8);
#define PG8_SA(b, h) (((b) * 2 + (h)) * HTB)
#define PG8_SB(b, h) ((4 + (b) * 2 + (h)) * HTB)
#define PG8_STAGE(bufoff, gbase, voff) do { _Pragma("unroll") for (int _i = 0; _i < 2; ++_i) \
        __builtin_amdgcn_global_load_lds((const unsigned*)((const char*)(gbase) + (voff)[_i]), (LAS unsigned*)(lds + (bufoff) + ldsw + _i * 8192), 16, 0, 0); } while (0)
#define PG8_LDA(dst, b, h) do { _Pragma("unroll") for (int m = 0; m < 4; ++m) _Pragma("unroll") for (int k = 0; k < 2; ++k) dst[m][k] = *(const LAS bf16x8*)(lds + PG8_SA(b, h) + aoff + m * 2048 + k * 1024); } while (0)
#define PG8_LDB(dst, b, h) do { _Pragma("unroll") for (int n = 0; n < 2; ++n) _Pragma("unroll") for (int k = 0; k < 2; ++k) dst[n][k] = *(const LAS bf16x8*)(lds + PG8_SB(b, h) + boff + n * 2048 + k * 1024); } while (0)
#define PG8_MMA(ai, bj, At, Bt) do { __builtin_amdgcn_s_setprio(1); _Pragma("unroll") for (int m = 0; m < 4; ++m) _Pragma("unroll") for (int n = 0; n < 2; ++n) _Pragma("unroll") for (int k = 0; k < 2; ++k) \
        acc[ai][bj][m][n] = __builtin_amdgcn_mfma_f32_16x16x32_bf16(Bt[n][k], At[m][k], acc[ai][bj][m][n], 0, 0, 0); __builtin_amdgcn_s_setprio(0); } while (0)
#define PG8_WAIT_V(n) asm volatile("s_waitcnt vmcnt(" #n ")" ::: "memory")
#define PG8_WAIT_L(n) asm volatile("s_waitcnt lgkmcnt(" #n ")" ::: "memory")
#define PG8_BAR __builtin_amdgcn_s_barrier()
#define PG8_SCHED __builtin_amdgcn_sched_barrier(0)
    Unit cur, nxt; int ui = 0;
    if (!S.next(0, cur)) return;
    if constexpr (Epi::USES_RS) {
        LAS float* tab = (LAS float*)(lds + RS_OFF);
        int k = 0, lastpm = -1; Unit tu;
        for (int i = 0; S.next(i, tu); ++i) {
            if (tu.pm != lastpm) { if ((k & 1) == (tid >> 8) && k < RS_NTAB) tab[k * 256 + (tid & 255)] = row_rs_g(E.ss(), tu.pm * 256 + (tid & 255)); ++k; lastpm = tu.pm; }
        }
        E.phase_init(lds, tid);
        __syncthreads();
    }
    f32x4 acc[2][2][4][2];
#pragma unroll
    for (int a = 0; a < 2; ++a)
#pragma unroll
        for (int b = 0; b < 2; ++b)
#pragma unroll
            for (int m = 0; m < 4; ++m)
#pragma unroll
                for (int n = 0; n < 2; ++n) acc[a][b][m][n] = (f32x4){0.f, 0.f, 0.f, 0.f};
    bf16x8 At[4][2], B0[2][2], B1[2][2];
    const char* cA = (const char*)g.A + (size_t)cur.pm * tstep + (size_t)cur.kt0 * kstep; const char* cB = (const char*)g.Bt + (size_t)cur.pn * tstep + (size_t)cur.kt0 * kstep;
    PG8_STAGE(PG8_SB(0, 0), cB, voffB); PG8_STAGE(PG8_SA(0, 0), cA, voffA); PG8_STAGE(PG8_SB(0, 1), cB + hstep, voffB); PG8_STAGE(PG8_SA(0, 1), cA + hstep, voffA);
    if (wr == 1) PG8_BAR;
    PG8_WAIT_V(4); PG8_BAR;
    PG8_STAGE(PG8_SB(1, 0), cB + kstep, voffB); PG8_STAGE(PG8_SA(1, 0), cA + kstep, voffA); PG8_STAGE(PG8_SB(1, 1), cB + hstep + kstep, voffB);
    PG8_WAIT_V(6); PG8_BAR;
    for (;;) {
        const bool has_next = S.next(ui + 1, nxt);
        const char* nA = has_next ? (const char*)g.A + (size_t)nxt.pm * tstep + (size_t)nxt.kt0 * kstep : cA; const char* nB = has_next ? (const char*)g.Bt + (size_t)nxt.pn * tstep + (size_t)nxt.kt0 * kstep : cB;
        const int nt = cur.nkt;
        for (int t = 0; t < nt; t += 2) {
            const bool last = (t == nt - 2);
            const char* a1 = cA + (size_t)(t + 1) * kstep;
            const char* a2 = last ? nA : cA + (size_t)(t + 2) * kstep; const char* b2 = last ? nB : cB + (size_t)(t + 2) * kstep;
            const char* a3 = a2 + kstep; const char* b3 = b2 + kstep;
            PG8_LDB(B0, 0, 0); PG8_SCHED; PG8_LDA(At, 0, 0); PG8_STAGE(PG8_SA(1, 1), a1 + hstep, voffA);
            PG8_WAIT_L(8); PG8_BAR; PG8_WAIT_L(0); PG8_MMA(0, 0, At, B0); PG8_BAR; PG8_SCHED;
            PG8_LDB(B1, 0, 1); PG8_STAGE(PG8_SB(0, 0), b2, voffB);
            PG8_BAR; PG8_WAIT_L(0); PG8_MMA(0, 1, At, B1); PG8_BAR;
            PG8_LDA(At, 0, 1); PG8_STAGE(PG8_SA(0, 0), a2, voffA);
            PG8_BAR; PG8_WAIT_L(0); PG8_MMA(1, 0, At, B0); PG8_BAR; PG8_SCHED;
            PG8_STAGE(PG8_SB(0, 1), b2 + hstep, voffB);
            PG8_WAIT_V(6); PG8_BAR; PG8_MMA(1, 1, At, B1); PG8_BAR;
            PG8_LDB(B0, 1, 0); PG8_SCHED; PG8_LDA(At, 1, 0); PG8_STAGE(PG8_SA(0, 1), a2 + hstep, voffA);
            PG8_WAIT_L(8); PG8_BAR; PG8_WAIT_L(0); PG8_MMA(0, 0, At, B0); PG8_BAR; PG8_SCHED;
            PG8_LDB(B1, 1, 1); PG8_STAGE(PG8_SB(1, 0), b3, voffB);
            PG8_BAR; PG8_WAIT_L(0); PG8_MMA(0, 1, At, B1); PG8_BAR;
            PG8_LDA(At, 1, 1); PG8_STAGE(PG8_SA(1, 0), a3, voffA);
            PG8_BAR; PG8_WAIT_L(0); PG8_MMA(1, 0, At, B0); PG8_BAR; PG8_SCHED;
            PG8_STAGE(PG8_SB(1, 1), b3 + hstep, voffB);
            PG8_WAIT_V(6); PG8_BAR; PG8_MMA(1, 1, At, B1); PG8_BAR;
        }
        if (cur.part < 0) E(acc, cur, wr, wc, fr, fq, lds);
        if (!has_next) break;
        if (!E.keep(cur)) {
#pragma unroll
            for (int a = 0; a < 2; ++a)
#pragma unroll
                for (int b = 0; b < 2; ++b)
#pragma unroll
                    for (int m = 0; m < 4; ++m)
#pragma unroll
                        for (int n = 0; n < 2; ++n) acc[a][b][m][n] = (f32x4){0.f, 0.f, 0.f, 0.f};
        }
        nxt.rk = cur.rk + (nxt.pm != cur.pm ? 1 : 0);
        cur = nxt; cA = nA; cB = nB; ++ui;
    }
    PG8_WAIT_V(0);
    if (wr == 0) PG8_BAR;
    PG8_BAR;
    {
      if (Sched::nparts > 1 && cur.part >= 0) {
        constexpr int np = Sched::nparts;
        float* sl = S.slab + (size_t)(cur.tt * np) * 65536 + (size_t)tid * 4;
        { float* mine = sl + (size_t)cur.part * 65536;
#pragma unroll
          for (int a = 0; a < 2; ++a)
#pragma unroll
            for (int b = 0; b < 2; ++b)
#pragma unroll
                for (int m = 0; m < 4; ++m)
#pragma unroll
                    for (int n = 0; n < 2; ++n) *(f32x4*)(mine + (size_t)(((a * 2 + b) * 4 + m) * 2 + n) * 2048) = acc[a][b][m][n]; }
        asm volatile("s_waitcnt vmcnt(0)" ::: "memory");
        __syncthreads();
        volatile LAS unsigned* flag = (volatile LAS unsigned*)(lds + STAGE_BYTES + 8);
        if (tid == 0) {
            __builtin_amdgcn_fence(__ATOMIC_RELEASE, "agent");
            asm volatile("s_waitcnt vmcnt(0)" ::: "memory");
            const unsigned old = __hip_atomic_fetch_add(S.cnt + cur.tt, 1u, __ATOMIC_RELAXED, __HIP_MEMORY_SCOPE_AGENT);
            if (old == (unsigned)(np - 1)) { __builtin_amdgcn_fence(__ATOMIC_ACQUIRE, "agent"); asm volatile("s_waitcnt vmcnt(0)" ::: "memory"); }
            flag[0] = old;
        }
        __syncthreads();
        const unsigned old = flag[0];
        if (old == (unsigned)(np - 1)) {
            for (int p = 0; p < np; ++p) {
                if (p == cur.part) continue;
                const float* oth = sl + (size_t)p * 65536;
#pragma unroll
                for (int a = 0; a < 2; ++a)
#pragma unroll
                    for (int b = 0; b < 2; ++b) {
#pragma unroll
                        for (int m = 0; m < 4; ++m)
#pragma unroll
                            for (int n = 0; n < 2; ++n) acc[a][b][m][n] += *(const f32x4*)(oth + (size_t)(((a * 2 + b) * 4 + m) * 2 + n) * 2048);
                        asm volatile("" ::: "memory");
                    }
            }
            E(acc, cur, wr, wc, fr, fq, lds);
        }
        __syncthreads();
      }
    }
#undef PG8_SA
#undef PG8_SB
#undef PG8_STAGE
#undef PG8_LDA
#undef PG8_LDB
#undef PG8_MMA
#undef PG8_WAIT_V
#undef PG8_WAIT_L
#undef PG8_BAR
#undef PG8_SCHED
}
}
using pg8::Unit;

DI float row_rs(const float* SS, int row) {
    const f32x4* p = (const f32x4*)(SS + (size_t)row * 16);
    const f32x4 a = p[0], b = p[1], c = p[2], d = p[3];
    const float s = ((a[0] + a[1]) + (a[2] + a[3])) + ((b[0] + b[1]) + (b[2] + b[3])) + ((c[0] + c[1]) + (c[2] + c[3])) + ((d[0] + d[1]) + (d[2] + d[3]));
    return rsqrtf(s * (1.0f / 1024.0f) + EPS);
}
DI float row_rs4(const float* SS, int row, int fq) {
    const f32x4 a = *(const f32x4*)(SS + (size_t)row * 16 + 4 * fq);
    float s = (a[0] + a[1]) + (a[2] + a[3]);
    s += __shfl_xor(s, 16); s += __shfl_xor(s, 32);
    return rsqrtf(s * (1.0f / 1024.0f) + EPS);
}
DI float silu_mul(float a, float b) { return a * fast_rcp(1.0f + fast_exp2(-a * LOG2E)) * b; }
DI float sigmoidf_(float a) { return fast_rcp(1.0f + fast_exp2(-a * LOG2E)); }

struct EpiSwiglu {
    static constexpr bool PERM = true, USES_RS = true;
    bf16_t* H; const float* SS;
    DI const float* ss() const { return SS; }
    DI void phase_init(LAS unsigned char*, int) const {}
    DI bool keep(const Unit&) const { return false; }
    DI void operator()(f32x4 (&acc)[2][2][4][2], const Unit& u, int wr, int wc, int fr, int fq, LAS unsigned char* lds) const {
        const int row0 = u.pm * 256 + wr * 64 + fr, hc = u.pn * 128 + wc * 32 + 8 * fq;
        float rsv[8];
        { const LAS float* tab = (const LAS float*)(lds + RS_OFF) + u.rk * 256 + wr * 64 + fr;
#pragma unroll
          for (int i = 0; i < 8; ++i) rsv[i] = tab[(i >> 2) * 128 + (i & 3) * 16]; }
#pragma unroll
        for (int ai = 0; ai < 2; ++ai)
#pragma unroll
            for (int m = 0; m < 4; ++m) {
                const int row = row0 + ai * 128 + m * 16; const float rs = rsv[ai * 4 + m];
                const f32x4 a0 = acc[ai][0][m][0] * rs, a1 = acc[ai][0][m][1] * rs, b0 = acc[ai][1][m][0] * rs, b1 = acc[ai][1][m][1] * rs;
                u32x4 w;
                w.x = pk2(silu_mul(a0[0], b0[0]), silu_mul(a0[1], b0[1])); w.y = pk2(silu_mul(a0[2], b0[2]), silu_mul(a0[3], b0[3]));
                w.z = pk2(silu_mul(a1[0], b1[0]), silu_mul(a1[1], b1[1])); w.w = pk2(silu_mul(a1[2], b1[2]), silu_mul(a1[3], b1[3]));
                *(u32x4*)(H + (size_t)row * DFF + hc) = w;
            }
    }
};

struct EpiResid {
    static constexpr bool PERM = false, USES_RS = false;
    const float* xin_p; const float* xin_s; float* X; bf16_t* XB; float* SS; float scale; bool wxb;
    DI bool keep(const Unit&) const { return false; }
    DI void operator()(f32x4 (&acc)[2][2][4][2], const Unit& u, int wr, int wc, int fr, int fq, LAS unsigned char* lds) const {
        const int row0 = u.pm * 256 + wr * 64 + fr, col0 = u.pn * 256 + wc * 32 + 4 * fq;
#pragma unroll
        for (int ai = 0; ai < 2; ++ai) {
            f32x4 xv[4][2][2];
#pragma unroll
            for (int m = 0; m < 4; ++m) {
                const int row = row0 + ai * 128 + m * 16;
                const float* xi = (row < TP ? xin_p + (size_t)row * DM : xin_s + (size_t)(row - TP) * DM) + col0;
#pragma unroll
                for (int bj = 0; bj < 2; ++bj)
#pragma unroll
                    for (int n = 0; n < 2; ++n) xv[m][bj][n] = *(const f32x4*)(xi + bj * 128 + n * 16);
            }
#pragma unroll
            for (int m = 0; m < 4; ++m) {
                const int row = row0 + ai * 128 + m * 16;
                float* xo = X + (size_t)row * DM + col0; bf16_t* xb = XB + (size_t)row * DM + col0;
                float ssq = 0.f;
#pragma unroll
                for (int bj = 0; bj < 2; ++bj)
#pragma unroll
                    for (int n = 0; n < 2; ++n) {
                        const int c = bj * 128 + n * 16;
                        const f32x4 o = xv[m][bj][n] + acc[ai][bj][m][n] * scale;
                        *(f32x4*)(xo + c) = o;
                        if (wxb) { u32x2 w; w.x = pk2(o[0], o[1]); w.y = pk2(o[2], o[3]); *(u32x2*)(xb + c) = w; }
                        ssq += (o[0] * o[0] + o[1] * o[1]) + (o[2] * o[2] + o[3] * o[3]);
                    }
                ssq += __shfl_xor(ssq, 16); ssq += __shfl_xor(ssq, 32);
                if (fq == 0) SS[(size_t)row * 16 + u.pn * 4 + wc] = ssq;
            }
        }
    }
};

struct EpiProj {
    static constexpr bool PERM = true, USES_RS = true;
    DI const float* ss() const { return (const float*)(ws + WS_SS); }
    DI void phase_init(LAS unsigned char* lds, int tid) const { *(LAS f32x4*)(lds + BG_OFF + tid * 16) = *(const f32x4*)(bgate + tid * 4); }
    unsigned char* ws; const float* bgate; float* out; int layer;
    DI bool keep(const Unit&) const { return false; }
    DI void operator()(f32x4 (&acc)[2][2][4][2], const Unit& u, int wr, int wc, int fr, int fq, LAS unsigned char* lds) const {
        bf16_t* const QA = (bf16_t*)(ws + WS_REG + REG_QA); bf16_t* const QB = (bf16_t*)(ws + WS_REG + REG_QB); bf16_t* const GATES = (bf16_t*)(ws + WS_REG + REG_GATES);
        bf16_t* const KA = (bf16_t*)(ws + WS_KA); bf16_t* const VA = (bf16_t*)(ws + WS_VA); bf16_t* const KB = (bf16_t*)(ws + WS_KB); bf16_t* const VB = (bf16_t*)(ws + WS_VB);
        const float* const ROPE = (const float*)(ws + WS_ROPE);
        const int row0 = u.pm * 256 + wr * 64 + fr, cw = wc * 32 + 8 * fq;
        const bool rope_wave = (wc & 1) == 0;
        float rsv[8];
        { const LAS float* tab = (const LAS float*)(lds + RS_OFF) + u.rk * 256 + wr * 64 + fr;
#pragma unroll
          for (int i = 0; i < 8; ++i) rsv[i] = tab[(i >> 2) * 128 + (i & 3) * 16]; }
#pragma unroll
        for (int ai = 0; ai < 2; ++ai)
#pragma unroll
            for (int m = 0; m < 4; ++m) {
                const int row = row0 + ai * 128 + m * 16; const float rs = rsv[ai * 4 + m];
                int posidx; long offA, offB;
                const bool prm = row < TP;
                if (prm) { const int b = row >> 13, t = row & 8191; posidx = t;
                    offA = t >= 8064 ? ((long)(layer * 4 + b) * 128 + (t - 8064)) * 128 : -1;
                    offB = t >= 7680 ? ((long)(layer * 4 + b) * 512 + (t - 7680)) * 512 : -1;
                } else { const int sb = (row - TP) >> 6, t = (row - TP) & 63; posidx = 8192 + t;
                    offA = ((long)(layer * 32 + sb) * 128 + 64 + t) * 128;
                    offB = ((long)(layer * 32 + sb) * 512 + 448 + t) * 512; }
#pragma unroll
                for (int bj = 0; bj < 2; ++bj) {
                    const int gcol = u.pn * 256 + bj * 128;
                    f32x4 v0 = acc[ai][bj][m][0] * rs, v1 = acc[ai][bj][m][1] * rs;
                    if (gcol < 768 && gcol != 640) {
                        if (rope_wave) {
                            const float* rp = ROPE + (size_t)posidx * 16;
                            const f32x4 cs0 = *(const f32x4*)rp, cs1 = *(const f32x4*)(rp + 4), sn0 = *(const f32x4*)(rp + 8), sn1 = *(const f32x4*)(rp + 12);
                            f32x4 p0, p1;
#pragma unroll
                            for (int j = 0; j < 4; ++j) { p0[j] = __shfl_xor(v0[j], 16); p1[j] = __shfl_xor(v1[j], 16); }
                            if (fq == 0) { v0 = v0 * cs0 - p0 * sn0; v1 = v1 * cs1 - p1 * sn1; }
                            else if (fq == 1) { v0 = v0 * cs0 + p0 * sn0; v1 = v1 * cs1 + p1 * sn1; }
                        }
                    }
                    bf16_t* dst; int ld, c0; float* of = nullptr; long orow = -1;
                    if (gcol < 512) { dst = QA; ld = 512; c0 = gcol; v0 = v0 * QSCALE; v1 = v1 * QSCALE; }
                    else if (gcol < 640) { dst = KA; ld = 128; c0 = gcol - 512; of = out + (prm ? O_KWP : O_KWS); orow = offA; }
                    else if (gcol < 768) { dst = VA; ld = 128; c0 = gcol - 640; of = out + (prm ? O_VWP : O_VWS); orow = offA; }
                    else if (gcol < 1280) { dst = QB; ld = 512; c0 = gcol - 768; v0 = v0 * QSCALE; v1 = v1 * QSCALE; }
                    else if (gcol < 1792) { dst = KB; ld = 512; c0 = gcol - 1280; of = out + (prm ? O_KBP : O_KBS); orow = offB; }
                    else if (gcol < 2304) { dst = VB; ld = 512; c0 = gcol - 1792; of = out + (prm ? O_VBP : O_VBS); orow = offB; }
                    else { dst = GATES; ld = 2048; c0 = gcol - 2304;
                        const f32x4 g0 = *(const LAS f32x4*)(lds + BG_OFF + (c0 + cw) * 4), g1 = *(const LAS f32x4*)(lds + BG_OFF + (c0 + cw + 4) * 4);
#pragma unroll
                        for (int j = 0; j < 4; ++j) { v0[j] = sigmoidf_(v0[j] + g0[j]); v1[j] = sigmoidf_(v1[j] + g1[j]); } }
                    u32x4 w; w.x = pk2(v0[0], v0[1]); w.y = pk2(v0[2], v0[3]); w.z = pk2(v1[0], v1[1]); w.w = pk2(v1[2], v1[3]);
                    *(u32x4*)(dst + (size_t)row * ld + c0 + cw) = w;
                    if (of != nullptr && orow >= 0) { float* op = of + orow + c0 + cw; *(f32x4*)op = v0; *(f32x4*)(op + 4) = v1; }
                }
            }
    }
};

struct EpiMerge {
    static constexpr bool PERM = true, USES_RS = false;
    const bf16_t* GATES; bf16_t* MB;
    DI bool keep(const Unit& u) const { return u.pm < T / 256; }
    DI void operator()(f32x4 (&acc)[2][2][4][2], const Unit& u, int wr, int wc, int fr, int fq, LAS unsigned char* lds) const {
        const int s = u.pm >= T / 256 ? 1 : 0;
        const int row0 = (u.pm - s * (T / 256)) * 256 + wr * 64 + fr, col0 = (u.pn - s * 4) * 256 + wc * 32 + 8 * fq;
#pragma unroll
        for (int ai = 0; ai < 2; ++ai) {
            u32x4 gbv[4][2], gav[4][2];
#pragma unroll
            for (int m = 0; m < 4; ++m) {
                const bf16_t* gp = GATES + (size_t)(row0 + ai * 128 + m * 16) * 2048 + col0;
#pragma unroll
                for (int bj = 0; bj < 2; ++bj) { gbv[m][bj] = *(const u32x4*)(gp + 1024 + bj * 128); if (s == 0) gav[m][bj] = *(const u32x4*)(gp + bj * 128); }
            }
#pragma unroll
            for (int m = 0; m < 4; ++m) {
                const int row = row0 + ai * 128 + m * 16;
#pragma unroll
                for (int bj = 0; bj < 2; ++bj) {
                    const u32x4 gb = gbv[m][bj];
                    float gbf[8];
#pragma unroll
                    for (int q = 0; q < 4; ++q) { gbf[2 * q] = __uint_as_float(gb[q] << 16); gbf[2 * q + 1] = __uint_as_float(gb[q] & 0xffff0000u); }
                    if (s == 0) {
                        const u32x4 ga = gav[m][bj];
#pragma unroll
                        for (int q = 0; q < 4; ++q) {
                            const float a0 = __uint_as_float(ga[q] << 16), a1 = __uint_as_float(ga[q] & 0xffff0000u);
                            const int n = q >> 1, j = (q & 1) * 2;
                            acc[ai][bj][m][n][j] *= a0 * fast_rcp(gbf[2 * q]); acc[ai][bj][m][n][j + 1] *= a1 * fast_rcp(gbf[2 * q + 1]);
                        }
                    } else {
                        u32x4 w;
#pragma unroll
                        for (int q = 0; q < 4; ++q) { const int n = q >> 1, j = (q & 1) * 2; w[q] = pk2(acc[ai][bj][m][n][j] * gbf[2 * q], acc[ai][bj][m][n][j + 1] * gbf[2 * q + 1]); }
                        *(u32x4*)(MB + (size_t)row * DM + col0 + bj * 128) = w;
                    }
                }
            }
        }
    }
};

constexpr int SM_STAGE = 24576, SM_NST = 5, SM_PART = SM_NST * SM_STAGE;
DI void small_kloop(LAS unsigned char* lds, f32x16& acc, const bf16_t* Ap, const bf16_t* Bp, int K, int nkt, int tid, int wm, int wn, int ql, int h) {
    const int wv = tid >> 6, l = tid & 63, r8 = l >> 3, p = l & 7;
    const char* ga = (const char*)(Ap + (size_t)(8 * wv + r8) * K) + ((p ^ r8) << 4);
    const char* gb0 = (const char*)(Bp + (size_t)(8 * wv + r8) * K) + ((p ^ r8) << 4);
    const char* gb1 = (const char*)(Bp + (size_t)(64 + 8 * wv + r8) * K) + ((p ^ r8) << 4);
    const unsigned la = (unsigned)wv * 1024u, lb0 = 8192u + (unsigned)wv * 1024u, lb1 = 8192u + 8192u + (unsigned)wv * 1024u;
#define SM_ISSUE(kt_, slot_) do { const int _k = (kt_) < nkt ? (kt_) : nkt - 1; LAS unsigned char* _st = lds + (slot_) * SM_STAGE; \
        __builtin_amdgcn_global_load_lds((const unsigned*)(ga + (size_t)_k * 128), (LAS unsigned*)(_st + la), 16, 0, 0); \
        __builtin_amdgcn_global_load_lds((const unsigned*)(gb0 + (size_t)_k * 128), (LAS unsigned*)(_st + lb0), 16, 0, 0); \
        __builtin_amdgcn_global_load_lds((const unsigned*)(gb1 + (size_t)_k * 128), (LAS unsigned*)(_st + lb1), 16, 0, 0); } while (0)
    __syncthreads();
    SM_ISSUE(0, 0); SM_ISSUE(1, 1); SM_ISSUE(2, 2); SM_ISSUE(3, 3);
    const int ra = 32 * wm + ql, rb = 32 * wn + ql;
    const unsigned aoff = (unsigned)ra * 128u, boff = 8192u + (unsigned)rb * 128u, sa = (unsigned)(ra & 7), sb = (unsigned)(rb & 7);
    int slot = 0, islot = 4;
#pragma nounroll
    for (int kt = 0; kt < nkt; ++kt) {
        asm volatile("s_waitcnt vmcnt(9)" ::: "memory");
        __builtin_amdgcn_s_barrier();
        asm volatile("" ::: "memory");
        SM_ISSUE(kt + 4, islot);
        const LAS unsigned char* st = lds + slot * SM_STAGE;
#pragma unroll
        for (int s = 0; s < 4; ++s) {
            const bf16x8 a = *(const LAS bf16x8*)(st + aoff + (((unsigned)(2 * s + h) ^ sa) << 4));
            const bf16x8 b = *(const LAS bf16x8*)(st + boff + (((unsigned)(2 * s + h) ^ sb) << 4));
            acc = __builtin_amdgcn_mfma_f32_32x32x16_bf16(a, b, acc, 0, 0, 0);
        }
        islot = slot; slot = slot == SM_NST - 1 ? 0 : slot + 1;
    }
    asm volatile("s_waitcnt vmcnt(0)" ::: "memory");
    __builtin_amdgcn_s_barrier();
    asm volatile("" ::: "memory");
#undef SM_ISSUE
}
DI void small_resid(LAS unsigned char* lds, const bf16_t* A, const bf16_t* Bt, int K, const float* xin, float* X, bf16_t* XB, float* SS, float scale, bool wxb = true) {
    int tid_ = threadIdx.x; asm volatile("" : "+v"(tid_));
    const int tid = tid_, wid = __builtin_amdgcn_readfirstlane(tid >> 6), lane = tid & 63, wm = wid >> 2, wn = wid & 3, ql = lane & 31, h = lane >> 5;
    for (int u = blockIdx.x; u < 256; u += gridDim.x) {
        const int tm = u >> 3, tn = u & 7;
        f32x16 acc;
#pragma unroll
        for (int r = 0; r < 16; ++r) acc[r] = 0.f;
        small_kloop(lds, acc, A + (size_t)(tm * 64) * K, Bt + (size_t)(tn * 128) * K, K, K / 64, tid, wm, wn, ql, h);
        LAS float* part = (LAS float*)(lds + SM_PART);
        const int col = tn * 128 + 32 * wn + ql;
#pragma unroll
        for (int r = 0; r < 16; ++r) {
            const int rl = 32 * wm + (r & 3) + 8 * (r >> 2) + 4 * h; const size_t e = (size_t)(tm * 64 + rl) * DM + col;
            const float o = xin[e] + scale * acc[r];
            X[e] = o; if (wxb) XB[e] = (bf16_t)(pk2(o, 0.f) & 0xffffu);
            float q = o * o;
            q += __shfl_xor(q, 1); q += __shfl_xor(q, 2); q += __shfl_xor(q, 4); q += __shfl_xor(q, 8); q += __shfl_xor(q, 16);
            if (ql == 0) part[rl * 4 + wn] = q;
        }
        __syncthreads();
        if (tid < 128) { const int rl = tid >> 1, pr = tid & 1; SS[(size_t)(tm * 64 + rl) * 16 + tn * 2 + pr] = part[rl * 4 + 2 * pr] + part[rl * 4 + 2 * pr + 1]; }
    }
    __syncthreads();
}
DI void small_merge(LAS unsigned char* lds, const bf16_t* YA, const bf16_t* YB, const bf16_t* W4, const bf16_t* GATES, bf16_t* MB) {
    int tid_ = threadIdx.x; asm volatile("" : "+v"(tid_));
    const int tid = tid_, wid = __builtin_amdgcn_readfirstlane(tid >> 6), lane = tid & 63, wm = wid >> 2, wn = wid & 3, ql = lane & 31, h = lane >> 5;
    for (int u = blockIdx.x; u < 256; u += gridDim.x) {
        const int tm = u >> 3, tn = u & 7;
        f32x16 acc, acc2;
#pragma unroll
        for (int r = 0; r < 16; ++r) { acc[r] = 0.f; acc2[r] = 0.f; }
        small_kloop(lds, acc, YA + (size_t)(tm * 64) * 512, W4 + (size_t)(tn * 128) * 512, 512, 8, tid, wm, wn, ql, h);
        small_kloop(lds, acc2, YB + (size_t)(tm * 64) * 512, W4 + (size_t)(1024 + tn * 128) * 512, 512, 8, tid, wm, wn, ql, h);
        const int col = tn * 128 + 32 * wn + ql;
#pragma unroll
        for (int r = 0; r < 16; ++r) {
            const int rl = 32 * wm + (r & 3) + 8 * (r >> 2) + 4 * h; const size_t row = (size_t)(tm * 64 + rl);
            const float ga = __uint_as_float((unsigned)GATES[row * 2048 + col] << 16), gb = __uint_as_float((unsigned)GATES[row * 2048 + 1024 + col] << 16);
            MB[row * DM + col] = (bf16_t)(pk2(ga * acc[r] + gb * acc2[r], 0.f) & 0xffffu);
        }
    }
    __syncthreads();
}

DI void tr_job(LAS float* tile, const float* __restrict__ src, bf16_t* __restrict__ dst, const float* __restrict__ g, int K, int N, int perm, int& tbase) {
    const int G = gridDim.x, nk = K / 64, ntile = nk * (N / 64), tid = threadIdx.x;
    int first = ((int)blockIdx.x - tbase % G) % G; if (first < 0) first += G;
    for (int t = first; t < ntile; t += G) {
        const int tn = t / nk, tk = t % nk; const int nb = tn * 64;
        const int scol = perm ? (((nb & 255) < 128) ? (nb >> 8) * 128 + (nb & 255) : DFF + (nb >> 8) * 128 + (nb & 255) - 128) : nb;
        const int ty = tid >> 4, tx = tid & 15;
#pragma unroll
        for (int i = 0; i < 2; ++i) { const int k = ty + 32 * i; f32x4 v = *(const f32x4*)(src + (size_t)(tk * 64 + k) * N + scol + 4 * tx);
            if (g) v = v * g[tk * 64 + k];
            tile[k * 65 + 4 * tx] = v[0]; tile[k * 65 + 4 * tx + 1] = v[1]; tile[k * 65 + 4 * tx + 2] = v[2]; tile[k * 65 + 4 * tx + 3] = v[3]; }
        __syncthreads();
        { const int n = tid >> 3, kp = tid & 7; float e[8];
#pragma unroll
          for (int j = 0; j < 8; ++j) e[j] = tile[(8 * kp + j) * 65 + n];
          u32x4 w; w.x = pk2(e[0], e[1]); w.y = pk2(e[2], e[3]); w.z = pk2(e[4], e[5]); w.w = pk2(e[6], e[7]);
          *(u32x4*)(dst + (size_t)(nb + n) * K + tk * 64 + 8 * kp) = w; }
        __syncthreads();
    }
    tbase += ntile;
}

DI void sincos_d(double a, float& c, float& s) {
    const double k = rint(a * 0.63661977236758134308);
    const double r = (a - k * 1.57079632679489655800) - k * 6.12323399573676603587e-17;
    const double r2 = r * r;
    const double sp = r * (1.0 + r2 * (-1.0 / 6 + r2 * (1.0 / 120 + r2 * (-1.0 / 5040 + r2 * (1.0 / 362880 + r2 * (-1.0 / 39916800 + r2 * (1.0 / 6227020800.0)))))));
    const double cp = 1.0 + r2 * (-0.5 + r2 * (1.0 / 24 + r2 * (-1.0 / 720 + r2 * (1.0 / 40320 + r2 * (-1.0 / 3628800 + r2 * (1.0 / 479001600.0 + r2 * (-1.0 / 87178291200.0)))))));
    const int q = ((int)k) & 3;
    const double sv = (q == 0) ? sp : (q == 1) ? cp : (q == 2) ? -sp : -cp;
    const double cv = (q == 0) ? cp : (q == 1) ? -sp : (q == 2) ? -cp : sp;
    c = (float)cv; s = (float)sv;
}

DI void prologue(const Params& P, LAS unsigned char* lds) {
    const int tid = threadIdx.x, G = gridDim.x, bid = blockIdx.x, lane = tid & 63, wid = tid >> 6;
    unsigned char* ws = P.ws;
    { LAS float* tile = (LAS float*)lds;
      constexpr int NT1 = (DM / 64) * (2 * DFF / 64), NT2 = (DFF / 64) * (DM / 64), NT3 = (DM / 64) * (DIN / 64), NT4 = (512 / 64) * (DM / 64), NT5 = (DM / 64) * (DM / 64);
      constexpr int C1 = NT1, C2 = C1 + NT2, C3 = C2 + NT3, C4 = C3 + NT4, C5 = C4 + NT4, C6 = C5 + NT5, C7 = C6 + NT1, C8 = C7 + NT2;
      const int ty = tid >> 4, tx = tid & 15, sn = tid >> 3, skp = tid & 7;
      const float* s0; const float* gp; bf16_t* dp; int sN;
      f32x4 v0 = {0.f, 0.f, 0.f, 0.f}, v1 = v0; float g0 = 1.f, g1 = 1.f;
#define TR_ADDR(t_, s0_, gp_, dp_, sN_) do { const int _l = (t_) / C8, _r = (t_) % C8; unsigned char* _wl = ws + WS_W + (size_t)_l * WL_B; \
        const float* _src; bf16_t* _dst; const float* _g = nullptr; int _K, _N, _perm = 0, _loc; \
        if (_r < C1) { _src = P.in[7] + (size_t)_l * DM * 2 * DFF; _dst = (bf16_t*)(_wl + WO1); _g = P.in[6] + _l * DM; _K = DM; _N = 2 * DFF; _perm = 1; _loc = _r; } \
        else if (_r < C2) { _src = P.in[8] + (size_t)_l * DFF * DM; _dst = (bf16_t*)(_wl + WO2); _K = DFF; _N = DM; _loc = _r - C1; } \
        else if (_r < C3) { _src = P.in[10] + (size_t)_l * DM * DIN; _dst = (bf16_t*)(_wl + WO3); _g = P.in[9] + _l * DM; _K = DM; _N = DIN; _loc = _r - C2; } \
        else if (_r < C4) { _src = P.in[14] + (size_t)_l * 512 * DM; _dst = (bf16_t*)(_wl + WO4); _K = 512; _N = DM; _loc = _r - C3; } \
        else if (_r < C5) { _src = P.in[15] + (size_t)_l * 512 * DM; _dst = (bf16_t*)(_wl + WO4) + (size_t)1024 * 512; _K = 512; _N = DM; _loc = _r - C4; } \
        else if (_r < C6) { _src = P.in[16] + (size_t)_l * DM * DM; _dst = (bf16_t*)(_wl + WO5); _K = DM; _N = DM; _loc = _r - C5; } \
        else if (_r < C7) { _src = P.in[18] + (size_t)_l * DM * 2 * DFF; _dst = (bf16_t*)(_wl + WO6); _g = P.in[17] + _l * DM; _K = DM; _N = 2 * DFF; _perm = 1; _loc = _r - C6; } \
        else { _src = P.in[19] + (size_t)_l * DFF * DM; _dst = (bf16_t*)(_wl + WO7); _K = DFF; _N = DM; _loc = _r - C7; } \
        const int _nk = _K / 64, _tn = _loc / _nk, _tk = _loc % _nk, _nb = _tn * 64; \
        const int _scol = _perm ? (((_nb & 255) < 128) ? (_nb >> 8) * 128 + (_nb & 255) : DFF + (_nb >> 8) * 128 + (_nb & 255) - 128) : _nb; \
        s0_ = _src + (size_t)(_tk * 64 + ty) * _N + _scol + 4 * tx; gp_ = _g ? _g + _tk * 64 + ty : nullptr; sN_ = _N; \
        dp_ = _dst + (size_t)(_nb + sn) * _K + _tk * 64 + 8 * skp; } while (0)
#define TR_BAR() do { asm volatile("s_waitcnt lgkmcnt(0)" ::: "memory"); __builtin_amdgcn_s_barrier(); asm volatile("" ::: "memory"); } while (0)
      int t = bid;
      if (t < NL * C8) { TR_ADDR(t, s0, gp, dp, sN); v0 = *(const f32x4*)s0; v1 = *(const f32x4*)(s0 + (size_t)32 * sN); if (gp) { g0 = gp[0]; g1 = gp[32]; } }
      while (t < NL * C8) {
          const f32x4 a = v0 * g0, b = v1 * g1;
          bf16_t* const dcur = dp;
          const int tn_ = t + G; g0 = 1.f; g1 = 1.f;
          if (tn_ < NL * C8) { TR_ADDR(tn_, s0, gp, dp, sN); v0 = *(const f32x4*)s0; v1 = *(const f32x4*)(s0 + (size_t)32 * sN); if (gp) { g0 = gp[0]; g1 = gp[32]; } }
          tile[ty * 65 + 4 * tx] = a[0]; tile[ty * 65 + 4 * tx + 1] = a[1]; tile[ty * 65 + 4 * tx + 2] = a[2]; tile[ty * 65 + 4 * tx + 3] = a[3];
          tile[(ty + 32) * 65 + 4 * tx] = b[0]; tile[(ty + 32) * 65 + 4 * tx + 1] = b[1]; tile[(ty + 32) * 65 + 4 * tx + 2] = b[2]; tile[(ty + 32) * 65 + 4 * tx + 3] = b[3];
          TR_BAR();
          { float e[8];
#pragma unroll
            for (int j = 0; j < 8; ++j) e[j] = tile[(8 * skp + j) * 65 + sn];
            u32x4 w; w.x = pk2(e[0], e[1]); w.y = pk2(e[2], e[3]); w.z = pk2(e[4], e[5]); w.w = pk2(e[6], e[7]);
            *(u32x4*)dcur = w; }
          TR_BAR();
          t = tn_;
      }
      asm volatile("s_waitcnt vmcnt(0)" ::: "memory");
      __syncthreads();
#undef TR_ADDR
#undef TR_BAR
    }
    { bf16_t* XB = (bf16_t*)(ws + WS_XB); float* SS = (float*)(ws + WS_SS);
      int row = bid * 8 + wid; f32x4 v[4];
#define XROW(r_) ((r_) < TP ? P.in[0] + (size_t)(r_) * DM : P.in[1] + (size_t)((r_) - TP) * DM)
      if (row < T) { const float* xr = XROW(row);
#pragma unroll
          for (int i = 0; i < 4; ++i) v[i] = *(const f32x4*)(xr + i * 256 + lane * 4); }
      while (row < T) {
          const int nrow = row + G * 8; f32x4 nv[4];
          if (nrow < T) { const float* xr = XROW(nrow);
#pragma unroll
              for (int i = 0; i < 4; ++i) nv[i] = *(const f32x4*)(xr + i * 256 + lane * 4); }
          else {
#pragma unroll
              for (int i = 0; i < 4; ++i) nv[i] = v[i]; }
          float ss = 0.f;
#pragma unroll
          for (int i = 0; i < 4; ++i) { ss += (v[i][0] * v[i][0] + v[i][1] * v[i][1]) + (v[i][2] * v[i][2] + v[i][3] * v[i][3]);
              u32x2 w; w.x = pk2(v[i][0], v[i][1]); w.y = pk2(v[i][2], v[i][3]); *(u32x2*)(XB + (size_t)row * DM + i * 256 + lane * 4) = w; }
#pragma unroll
          for (int o = 32; o >= 1; o >>= 1) ss += __shfl_xor(ss, o);
          if (lane < 16) SS[(size_t)row * 16 + lane] = lane == 0 ? ss : 0.f;
          row = nrow;
#pragma unroll
          for (int i = 0; i < 4; ++i) v[i] = nv[i];
      }
#undef XROW
    }
    { float* R = (float*)(ws + WS_ROPE);
      for (int e = bid * NTHR + tid; e < 8256 * 8; e += G * NTHR) {
          const int pi = e >> 3, i = e & 7; const int pos = pi < 8192 ? pi : 4096 + (pi - 8192);
          const double fr = (i == 0) ? 1.0 : (i == 1) ? 0.1939227432012558 : (i == 2) ? 0.03760603070259094 : (i == 3) ? 0.007292664609849453 : (i == 4) ? 0.0014142135623842478
                          : (i == 5) ? 0.00027424818836152554 : (i == 6) ? 5.3182957344688475e-05 : 1.0313385246263351e-05;
          const float angf = (float)pos * (float)fr;
          float c, s; sincos_d((double)angf, c, s);
          R[(size_t)pi * 16 + i] = c; R[(size_t)pi * 16 + 8 + i] = s;
      } }
}

DI void cache_copy_part(const Params& P, int part, int rank, int nranks) {
    int tid_ = threadIdx.x; asm volatile("" : "+v"(tid_));
    const size_t gt = (size_t)rank * NTHR + tid_, gs = (size_t)nranks * NTHR;
#define CP4(N_, PER_, SRCK_, SRCV_, DSTK_, DSTV_, BLK_, OFF_) do { const size_t _lo = (size_t)(N_) * part / 4, _hi = (size_t)(N_) * (part + 1) / 4; \
      for (size_t e0 = _lo + gt; e0 < _hi; e0 += 4 * gs) { f32x4 kv[4], vv[4]; \
          _Pragma("unroll") for (int q = 0; q < 4; ++q) { const size_t e = e0 + q * gs; if (e < _hi) { const size_t blk = e / (PER_), r = e % (PER_); \
              kv[q] = *(const f32x4*)((SRCK_) + blk * (BLK_) + (OFF_) + r * 4); vv[q] = *(const f32x4*)((SRCV_) + blk * (BLK_) + (OFF_) + r * 4); } } \
          _Pragma("unroll") for (int q = 0; q < 4; ++q) { const size_t e = e0 + q * gs; if (e < _hi) { const size_t blk = e / (PER_), r = e % (PER_); \
              *(f32x4*)((DSTK_) + blk * (BLK_) + r * 4) = kv[q]; *(f32x4*)((DSTV_) + blk * (BLK_) + r * 4) = vv[q]; } } } } while (0)
    CP4((size_t)2 * 32 * 2048, (size_t)2048, P.in[2], P.in[3], P.out + O_KWS, P.out + O_VWS, (size_t)16384, (size_t)8192);
    CP4((size_t)2 * 32 * 57344, (size_t)57344, P.in[4], P.in[5], P.out + O_KBS, P.out + O_VBS, (size_t)262144, (size_t)32768);
#undef CP4
}

constexpr int AT_KS = 0, AT_VT = 2 * 9216, AT_BT = 4 * 9216;
struct TileSrc { const unsigned char* k; const unsigned char* v; int f32; int ldb; };

DI void attn_phase(const Params& P, LAS unsigned char* lds, int layer) {
    int tid_ = threadIdx.x; asm volatile("" : "+v"(tid_));
    const int tid = tid_, lane = tid & 63, wid = __builtin_amdgcn_readfirstlane(tid >> 6), G = gridDim.x;
    unsigned char* ws = P.ws;
    const bf16_t* QA = (const bf16_t*)(ws + WS_REG + REG_QA); const bf16_t* QB = (const bf16_t*)(ws + WS_REG + REG_QB);
    const bf16_t* KA = (const bf16_t*)(ws + WS_KA); const bf16_t* VA = (const bf16_t*)(ws + WS_VA);
    const bf16_t* KBp = (const bf16_t*)(ws + WS_KB); const bf16_t* VBp = (const bf16_t*)(ws + WS_VB);
    bf16_t* YA = (bf16_t*)(ws + WS_XB); bf16_t* YB = YA + (size_t)T * 512;
    const float* ckw = P.in[2] + (size_t)layer * 32 * 128 * 128; const float* cvw = P.in[3] + (size_t)layer * 32 * 128 * 128;
    const float* ckb = P.in[4] + (size_t)layer * 32 * 512 * 512; const float* cvb = P.in[5] + (size_t)layer * 32 * 512 * 512;
    const float* sinks = P.in[12] + layer * 8; const float* relb = P.in[13] + (size_t)layer * 8 * 257;
    LAS float* bt = (LAS float*)(lds + AT_BT);
    const int key = tid >> 3, dp = tid & 7;
    const int ql = lane & 31, h = lane >> 5;

    for (int it = 0; it < 10; ++it) {
        const int c = blockIdx.x;
        int mixB, smp, b = 0, hk, c0 = 0, j0, j1, ncache = 0;
        if (it < 4) { const int bh = it * 8 + (c & 7); mixB = 1; smp = 0; b = bh >> 3; hk = bh & 7; c0 = 4 * (c >> 3); j0 = c0 - 8 < 0 ? 0 : c0 - 8; j1 = c0 + 3; }
        else if (it == 4) { mixB = 1; smp = 1; b = c >> 3; hk = c & 7; c0 = 8; j0 = 0; j1 = 8; ncache = 8; }
        else if (it < 9) { mixB = 0; smp = 0; b = it - 5; hk = c & 1; c0 = ((c & 7) >> 1) * 32 + (c >> 3); j0 = c0 - 2 < 0 ? 0 : c0 - 2; j1 = c0; }
        else { if (c >= 64) break; mixB = 0; smp = 1; b = c >> 1; hk = c & 1; c0 = 2; j0 = 0; j1 = 2; ncache = 2; }
        const int ldkv = mixB ? 512 : 128;
        const bf16_t* Kbuf = mixB ? KBp : KA; const bf16_t* Vbuf = mixB ? VBp : VA;
        const float* ck = mixB ? ckb : ckw; const float* cv = mixB ? cvb : cvw;
        const int clen = mixB ? 512 : 128, nh = mixB ? 8 : 2;
        int cw, hq, wlo, whi; long qrow0;
        if (!mixB) { cw = c0; hq = 4 * hk + (wid >> 1); wlo = j0; whi = j1; }
        else if (!smp) { cw = c0 + (wid >> 1); hq = hk; wlo = cw - 8 < 0 ? 0 : cw - 8; whi = cw; }
        else { cw = 8; hq = hk; wlo = wid < 2 ? 0 : 1; whi = wid < 2 ? 8 : 0; }
        qrow0 = (smp ? (long)TP + b * 64 : (long)b * 8192 + (long)cw * 64) + 32 * (wid & 1);
        const bool wave_on = wlo <= whi;
        const bf16_t* Qp = (mixB ? QB : QA) + (size_t)(qrow0 + ql) * 512 + hq * 64 + 8 * h;
        bf16x8 qf[4];
        if (wave_on) {
#pragma unroll
            for (int s = 0; s < 4; ++s) qf[s] = *(const bf16x8*)(Qp + 16 * s);
        } else {
#pragma unroll
            for (int s = 0; s < 4; ++s) qf[s] = (bf16x8){0, 0, 0, 0, 0, 0, 0, 0};
        }
        if (mixB) { for (int i = tid; i < 257; i += NTHR) bt[i] = relb[hk * 257 + i] * LOG2E; }
        const float sinkv = mixB ? -1e30f : sinks[hq] * LOG2E;
        float m_run = sinkv, l_run = 0.f;
        f32x16 O0, O1;
#pragma unroll
        for (int r = 0; r < 16; ++r) { O0[r] = 0.f; O1[r] = 0.f; }

        auto tsrc = [&](int j) -> TileSrc { TileSrc s;
            if (!smp) { const size_t row = (size_t)b * 8192 + (size_t)j * 64; s.k = (const unsigned char*)(Kbuf + row * ldkv + hk * 64); s.v = (const unsigned char*)(Vbuf + row * ldkv + hk * 64); s.f32 = 0; s.ldb = ldkv * 2; }
            else if (j < ncache) { const size_t e = (((size_t)b * clen + (size_t)j * 64) * nh + hk) * 64; s.k = (const unsigned char*)(ck + e); s.v = (const unsigned char*)(cv + e); s.f32 = 1; s.ldb = nh * 64 * 4; }
            else { const size_t row = (size_t)TP + (size_t)b * 64; s.k = (const unsigned char*)(Kbuf + row * ldkv + hk * 64); s.v = (const unsigned char*)(Vbuf + row * ldkv + hk * 64); s.f32 = 0; s.ldb = ldkv * 2; }
            return s; };
        u32x4 rg[4]; int rg_f32 = 0;
#define AT_LOAD(j, rg, rg_f32) do { const TileSrc _s = tsrc(j); rg_f32 = _s.f32; \
            if (_s.f32) { const unsigned char* kp = _s.k + (size_t)key * _s.ldb + dp * 32; const unsigned char* vp = _s.v + (size_t)key * _s.ldb + dp * 32; \
                rg[0] = *(const u32x4*)kp; rg[1] = *(const u32x4*)(kp + 16); rg[2] = *(const u32x4*)vp; rg[3] = *(const u32x4*)(vp + 16); } \
            else { rg[0] = *(const u32x4*)(_s.k + (size_t)key * _s.ldb + dp * 16); rg[2] = *(const u32x4*)(_s.v + (size_t)key * _s.ldb + dp * 16); \
                   rg[1] = (u32x4){0u, 0u, 0u, 0u}; rg[3] = (u32x4){0u, 0u, 0u, 0u}; } } while (0)
#define AT_WRITE(buf, rg, rg_f32) do { u32x4 kk, vv; \
            if (rg_f32) { kk.x = pk2(__uint_as_float(rg[0].x), __uint_as_float(rg[0].y)); kk.y = pk2(__uint_as_float(rg[0].z), __uint_as_float(rg[0].w)); \
                          kk.z = pk2(__uint_as_float(rg[1].x), __uint_as_float(rg[1].y)); kk.w = pk2(__uint_as_float(rg[1].z), __uint_as_float(rg[1].w)); \
                          vv.x = pk2(__uint_as_float(rg[2].x), __uint_as_float(rg[2].y)); vv.y = pk2(__uint_as_float(rg[2].z), __uint_as_float(rg[2].w)); \
                          vv.z = pk2(__uint_as_float(rg[3].x), __uint_as_float(rg[3].y)); vv.w = pk2(__uint_as_float(rg[3].z), __uint_as_float(rg[3].w)); } \
            else { kk = rg[0]; vv = rg[2]; } \
            *(LAS u32x4*)(lds + AT_KS + (buf) * 9216 + key * 144 + dp * 16) = kk; \
            LAS bf16_t* vt = (LAS bf16_t*)(lds + AT_VT + (buf) * 9216) + (8 * dp) * 72 + ((((key >> 2) ^ dp) << 2) | (key & 3)); \
            vt[0 * 72] = (bf16_t)(vv.x & 0xffffu); vt[1 * 72] = (bf16_t)(vv.x >> 16); vt[2 * 72] = (bf16_t)(vv.y & 0xffffu); vt[3 * 72] = (bf16_t)(vv.y >> 16); \
            vt[4 * 72] = (bf16_t)(vv.z & 0xffffu); vt[5 * 72] = (bf16_t)(vv.z >> 16); vt[6 * 72] = (bf16_t)(vv.w & 0xffffu); vt[7 * 72] = (bf16_t)(vv.w >> 16); } while (0)

        AT_LOAD(j0, rg, rg_f32); AT_WRITE(0, rg, rg_f32);
        __builtin_amdgcn_s_waitcnt(0);
#pragma unroll
        for (int s = 0; s < 4; ++s) asm volatile("" : "+v"(qf[s]));
        if (j0 < j1) AT_LOAD(j0 + 1, rg, rg_f32);
        asm volatile("s_waitcnt lgkmcnt(0)" ::: "memory"); __builtin_amdgcn_s_barrier(); asm volatile("" ::: "memory");
        for (int j = j0; j <= j1; ++j) {
            const int buf = (j - j0) & 1;
            if (wave_on && j >= wlo && j <= whi) {
                const LAS unsigned char* Ks = lds + AT_KS + buf * 9216; const LAS unsigned char* Vt = lds + AT_VT + buf * 9216;
                f32x16 S0, S1; bf16x8 kf0[4], kf1[4];
#pragma unroll
                for (int r = 0; r < 16; ++r) { S0[r] = 0.f; S1[r] = 0.f; }
#pragma unroll
                for (int s = 0; s < 4; ++s) { kf0[s] = *(const LAS bf16x8*)(Ks + ql * 144 + 32 * s + 16 * h); kf1[s] = *(const LAS bf16x8*)(Ks + (32 + ql) * 144 + 32 * s + 16 * h); }
                __builtin_amdgcn_sched_barrier(0);
#pragma unroll
                for (int s = 0; s < 4; ++s) {
                    S0 = __builtin_amdgcn_mfma_f32_32x32x16_bf16(kf0[s], qf[s], S0, 0, 0, 0);
                    S1 = __builtin_amdgcn_mfma_f32_32x32x16_bf16(kf1[s], qf[s], S1, 0, 0, 0);
                }
                bf16x8 vf0[4], vf1[4];
#pragma unroll
                for (int kb = 0; kb < 2; ++kb)
#pragma unroll
                    for (int s = 0; s < 2; ++s) {
                        const int kg = 8 * kb + 4 * s + h;
                        const int ko = (kg ^ (ql >> 3)) << 3, ko2 = ((kg + 2) ^ (ql >> 3)) << 3;
                        { const s16x4 lo = *(const LAS s16x4*)(Vt + ql * 144 + ko), hi = *(const LAS s16x4*)(Vt + ql * 144 + ko2);
                          vf0[kb * 2 + s] = __builtin_shufflevector(lo, hi, 0, 1, 2, 3, 4, 5, 6, 7); }
                        { const s16x4 lo = *(const LAS s16x4*)(Vt + (32 + ql) * 144 + (ko ^ 32)), hi = *(const LAS s16x4*)(Vt + (32 + ql) * 144 + (ko2 ^ 32));
                          vf1[kb * 2 + s] = __builtin_shufflevector(lo, hi, 0, 1, 2, 3, 4, 5, 6, 7); }
                    }
                __builtin_amdgcn_sched_barrier(0);
                if (mixB) {
                    const int rel0 = 64 * (j - cw);
                    if (rel0 <= -192) { const float bb = bt[0];
#pragma unroll
                        for (int r = 0; r < 16; ++r) { S0[r] += bb; S1[r] += bb; }
                    } else if (rel0 >= -64) {
                        const LAS float* bp = bt + (rel0 - (32 * (wid & 1) + ql) + 4 * h + 128);
#pragma unroll
                        for (int r = 0; r < 16; ++r) { const int kk = (r & 3) + 8 * (r >> 2); S0[r] += bp[kk]; S1[r] += bp[32 + kk]; }
                    } else {
                        const int base = rel0 - (32 * (wid & 1) + ql) + 4 * h + 128;
#pragma unroll
                        for (int r = 0; r < 16; ++r) { const int kk = (r & 3) + 8 * (r >> 2);
                            int i0 = base + kk, i1 = base + 32 + kk; i0 = i0 < 0 ? 0 : (i0 > 256 ? 256 : i0); i1 = i1 < 0 ? 0 : (i1 > 256 ? 256 : i1);
                            S0[r] += bt[i0]; S1[r] += bt[i1]; }
                    }
                }
                float mx = S0[0];
#pragma unroll
                for (int r = 1; r < 16; ++r) mx = fmaxf(mx, S0[r]);
#pragma unroll
                for (int r = 0; r < 16; ++r) mx = fmaxf(mx, S1[r]);
                mx = fmaxf(mx, __shfl_xor(mx, 32));
                const float mn = fmaxf(m_run, mx); const float alpha = fast_exp2(m_run - mn); m_run = mn;
                float ps = 0.f;
#pragma unroll
                for (int r = 0; r < 16; ++r) { S0[r] = fast_exp2(S0[r] - mn); S1[r] = fast_exp2(S1[r] - mn); ps += S0[r] + S1[r]; }
                l_run = l_run * alpha + ps;
#pragma unroll
                for (int r = 0; r < 16; ++r) { O0[r] *= alpha; O1[r] *= alpha; }
#pragma unroll
                for (int kb = 0; kb < 2; ++kb)
#pragma unroll
                    for (int s = 0; s < 2; ++s) {
                        u32x4 pw;
#pragma unroll
                        for (int q = 0; q < 4; ++q) pw[q] = kb == 0 ? pk2(S0[8 * s + 2 * q], S0[8 * s + 2 * q + 1]) : pk2(S1[8 * s + 2 * q], S1[8 * s + 2 * q + 1]);
                        const bf16x8 pf = __builtin_bit_cast(bf16x8, pw);
                        O0 = __builtin_amdgcn_mfma_f32_32x32x16_bf16(vf0[kb * 2 + s], pf, O0, 0, 0, 0);
                        O1 = __builtin_amdgcn_mfma_f32_32x32x16_bf16(vf1[kb * 2 + s], pf, O1, 0, 0, 0);
                    }
            }
            if (j < j1) { AT_WRITE(buf ^ 1, rg, rg_f32); if (j + 2 <= j1) AT_LOAD(j + 2, rg, rg_f32); }
            asm volatile("s_waitcnt lgkmcnt(0)" ::: "memory"); __builtin_amdgcn_s_barrier(); asm volatile("" ::: "memory");
        }
#undef AT_LOAD
#undef AT_WRITE
        if (wave_on) {
            float lt = l_run + __shfl_xor(l_run, 32);
            if (!mixB) lt += fast_exp2(sinkv - m_run);
            const float inv = 1.0f / lt;
            bf16_t* yp = (mixB ? YB : YA) + (size_t)(qrow0 + ql) * 512 + hq * 64 + 4 * h;
#pragma unroll
            for (int g4 = 0; g4 < 4; ++g4) {
                u32x2 w0, w1;
                w0.x = pk2(O0[4 * g4] * inv, O0[4 * g4 + 1] * inv); w0.y = pk2(O0[4 * g4 + 2] * inv, O0[4 * g4 + 3] * inv);
                w1.x = pk2(O1[4 * g4] * inv, O1[4 * g4 + 1] * inv); w1.y = pk2(O1[4 * g4 + 2] * inv, O1[4 * g4 + 3] * inv);
                *(u32x2*)(yp + 8 * g4) = w0; *(u32x2*)(yp + 32 + 8 * g4) = w1;
            }
        }
    }
}

DI void final_phase(const Params& P) {
    const int tid = threadIdx.x, lane = tid & 63, wid = tid >> 6, G = gridDim.x;
    const float* SS = (const float*)(P.ws + WS_SS); const float* g = P.in[20];
    f32x4 gv[4];
#pragma unroll
    for (int i = 0; i < 4; ++i) gv[i] = *(const f32x4*)(g + i * 256 + lane * 4);
    int row = blockIdx.x * 8 + wid; f32x4 v[4]; f32x4 sv = {0.f, 0.f, 0.f, 0.f};
    if (row < T) { const float* xr = P.out + O_Y + (size_t)row * DM; sv = *(const f32x4*)(SS + (size_t)row * 16 + 4 * (lane & 3));
#pragma unroll
        for (int i = 0; i < 4; ++i) v[i] = *(const f32x4*)(xr + i * 256 + lane * 4); }
    while (row < T) {
        const int nrow = row + G * 8; f32x4 nv[4]; f32x4 nsv = sv;
        if (nrow < T) { const float* xr = P.out + O_Y + (size_t)nrow * DM; nsv = *(const f32x4*)(SS + (size_t)nrow * 16 + 4 * (lane & 3));
#pragma unroll
            for (int i = 0; i < 4; ++i) nv[i] = *(const f32x4*)(xr + i * 256 + lane * 4); }
        else {
#pragma unroll
            for (int i = 0; i < 4; ++i) nv[i] = v[i]; }
        float t = (sv[0] + sv[1]) + (sv[2] + sv[3]); t += __shfl_xor(t, 1); t += __shfl_xor(t, 2);
        const float rs = rsqrtf(t * (1.0f / 1024.0f) + EPS);
        float* xo = P.out + O_Y + (size_t)row * DM;
#pragma unroll
        for (int i = 0; i < 4; ++i) *(f32x4*)(xo + i * 256 + lane * 4) = v[i] * rs * gv[i];
        row = nrow; sv = nsv;
#pragma unroll
        for (int i = 0; i < 4; ++i) v[i] = nv[i];
    }
}

#define XB_TMO      128
#define XB_XCNT(j)  (256  + 64 * (j))
#define XB_XSUB(j)  (1280 + 64 * (j))
#define XB_XGEN(j)  (2304 + 64 * (j))
#define XB_TOP      3328
#define XB_TOPGEN   3392
#define XCD_BAR_WORDS 3456
#define XB_SPIN_CAP (1u << 22)
DI unsigned xb_ld(unsigned* p) { return __hip_atomic_load(p, __ATOMIC_RELAXED, __HIP_MEMORY_SCOPE_AGENT); }
DI unsigned xb_add(unsigned* p, unsigned v) { return __hip_atomic_fetch_add(p, v, __ATOMIC_RELAXED, __HIP_MEMORY_SCOPE_AGENT); }
DI unsigned xb_xcc_id() { return (unsigned)__builtin_amdgcn_s_getreg((3 << 11) | 20) & 0xFu; }
#define XB_SPIN(cond, bar) do { unsigned _sp = 0; while (cond) { __builtin_amdgcn_s_sleep(1); \
    if ((++_sp & 255u) == 0u) { if (xb_ld(&(bar)[XB_TMO])) break; if (_sp > XB_SPIN_CAP) { atomicAdd(&(bar)[XB_TMO], 1u); break; } } } } while (0)
struct XcdBarrier { unsigned* bar; unsigned x; volatile LAS unsigned* st; };
DI XcdBarrier xcd_barrier_post(unsigned* bar, volatile LAS unsigned* st) {
    XcdBarrier b; b.bar = bar; b.x = xb_xcc_id(); b.st = st;
    if (threadIdx.x == 0) (void)xb_add(&bar[XB_XCNT(b.x)], 1u);
    return b;
}
DI void xcd_barrier_complete(unsigned* bar, unsigned x, unsigned& nloc, unsigned& nx) {
    const unsigned G = gridDim.x;
    unsigned sum, cnt, mine, sp = 0u;
    for (;;) {
        sum = 0u; cnt = 0u; mine = 0u;
#pragma unroll
        for (unsigned j = 0; j < 16; ++j) { const unsigned c = xb_ld(&bar[XB_XCNT(j)]); sum += c; cnt += (c > 0u) ? 1u : 0u; mine = (j == x) ? c : mine; }
        if (sum == G) break;
        __builtin_amdgcn_s_sleep(1);
        if ((++sp & 255u) == 0u) { if (xb_ld(&bar[XB_TMO])) break; if (sp > XB_SPIN_CAP) { atomicAdd(&bar[XB_TMO], 1u); break; } }
    }
    nloc = mine > 0u ? mine : 1u; nx = cnt > 0u ? cnt : 1u;
}
DI void xcd_barrier(const XcdBarrier& b) {
    asm volatile("s_waitcnt vmcnt(0)" ::: "memory");
    __syncthreads();
    if (threadIdx.x == 0) {
        unsigned* bar = b.bar;
        __builtin_amdgcn_s_waitcnt(0);
        unsigned nloc = b.st[0], nx = b.st[1];
        if (nloc == 0u) { xcd_barrier_complete(bar, b.x, nloc, nx); b.st[0] = nloc; b.st[1] = nx; }
        const unsigned old = xb_add(&bar[XB_XSUB(b.x)], 1u);
        const unsigned gen = old / nloc;
        if (old + 1u == (gen + 1u) * nloc) {
            __builtin_amdgcn_fence(__ATOMIC_RELEASE, "agent");
            asm volatile("s_waitcnt vmcnt(0)" ::: "memory");
            const unsigned og = xb_add(&bar[XB_TOP], 1u);
            const unsigned tg = og / nx;
            if (og + 1u == (tg + 1u) * nx) xb_add(&bar[XB_TOPGEN], 1u);
            else XB_SPIN(xb_ld(&bar[XB_TOPGEN]) == tg, bar);
            __builtin_amdgcn_fence(__ATOMIC_ACQUIRE, "agent");
            xb_add(&bar[XB_XGEN(b.x)], 1u);
            asm volatile("s_waitcnt vmcnt(0)" ::: "memory");
        } else {
            XB_SPIN(xb_ld(&bar[XB_XGEN(b.x)]) == gen, bar);
            __builtin_amdgcn_fence(__ATOMIC_ACQUIRE, "agent");
            asm volatile("s_waitcnt vmcnt(0)" ::: "memory");
        }
    }
    __syncthreads();
}

__global__ void __launch_bounds__(NTHR) fwd_megakernel(Params P, int ph_lo, int ph_hi) {
    extern __shared__ __attribute__((aligned(16))) unsigned char lds_raw[];
    LAS unsigned char* lds = (LAS unsigned char*)lds_raw;
    cg::grid_group grid = cg::this_grid();
    unsigned char* ws = P.ws; const int G = gridDim.x, bid = blockIdx.x;
    bf16_t* XB = (bf16_t*)(ws + WS_XB); float* SS = (float*)(ws + WS_SS); float* X = P.out + O_Y;
    bf16_t* HID = (bf16_t*)(ws + WS_REG); bf16_t* MB = (bf16_t*)(ws + WS_REG + REG_MB); bf16_t* GATES = (bf16_t*)(ws + WS_REG + REG_GATES);
    volatile LAS unsigned* xst = (volatile LAS unsigned*)(lds + pg8::STAGE_BYTES);
    if (threadIdx.x < 4) xst[threadIdx.x] = 0u;
    __syncthreads();
    if (blockIdx.x == 0) { unsigned* bw = (unsigned*)(ws + WS_BAR); for (int i = threadIdx.x; i < XCD_BAR_WORDS; i += NTHR) __hip_atomic_store(bw + i, 0u, __ATOMIC_RELAXED, __HIP_MEMORY_SCOPE_AGENT); }
    XcdBarrier xbar; xbar.bar = (unsigned*)(ws + WS_BAR); xbar.x = 0; xbar.st = xst;
    float* SLAB = (float*)(ws + WS_SLAB); unsigned* CNT = (unsigned*)(ws + WS_CNT);
    int ph = 0;
#define SEAM() do { ++ph; if (ph > ph_lo && ph < ph_hi) { if (ph == 1) grid.sync(); else xcd_barrier(xbar); } } while (0)
#define RUN (ph >= ph_lo && ph < ph_hi)
    if (RUN) prologue(P, lds);
    SEAM();
    xbar = xcd_barrier_post((unsigned*)(ws + WS_BAR), xst);
    for (int l = 0; l < NL; ++l) {
        const unsigned char* wl = ws + WS_W + (size_t)l * WL_B;
        for (int f = 0; f < 2; ++f) {
            if (f == 1) {
                if (RUN) { pg8::Gemm g{XB, (const bf16_t*)(wl + WO3), T, DIN, DM}; pg8::StaticOrder<T, DIN, DM, false, 1> S; S.init(bid, SLAB, CNT + ph * 256);
                    EpiProj E{ws, P.in[11] + l * 2048, P.out, l};
                    pg8::gemm_phase(lds, g, S, E); }
                SEAM();
                if (RUN) {
                    if (bid < 8) { pg8::Gemm g{XB, (const bf16_t*)(wl + WO3), T, DIN, DM}; pg8::StaticOrder<T, DIN, DM, false, 2> S; S.init(bid, SLAB, CNT + ph * 256);
                        EpiProj E{ws, P.in[11] + l * 2048, P.out, l};
                        pg8::gemm_phase(lds, g, S, E); }
                    attn_phase(P, lds, l); }
                SEAM();
                if (RUN) { pg8::Gemm g{XB  , (const bf16_t*)(wl + WO4), 2 * T, 2048, 512}; pg8::MergeOrder S; S.so.init(bid, nullptr, nullptr); S.slab = nullptr; S.cnt = nullptr;
                    EpiMerge E{GATES, MB}; pg8::gemm_phase(lds, g, S, E); }
                if (RUN) small_merge(lds, XB + (size_t)TP * 512, XB + (size_t)T * 512 + (size_t)TP * 512, (const bf16_t*)(wl + WO4), GATES + (size_t)TP * 2048, MB + (size_t)TP * DM);
                SEAM();
                if (RUN) { pg8::Gemm g{MB, (const bf16_t*)(wl + WO5), T, DM, DM}; pg8::StaticOrder<TP, DM, DM, false> S; S.init(bid, SLAB, CNT + ph * 256);
                    EpiResid E{X, X + (size_t)TP * DM, X, XB, SS, 1.0f, true}; pg8::gemm_phase(lds, g, S, E); }
                if (RUN) small_resid(lds, MB + (size_t)TP * DM, (const bf16_t*)(wl + WO5), DM, X + (size_t)TP * DM, X + (size_t)TP * DM, XB + (size_t)TP * DM, SS + (size_t)TP * 16, 1.0f);
                SEAM();
            }
            if (RUN) { pg8::Gemm g{XB, (const bf16_t*)(wl + (f ? WO6 : WO1)), T, 2 * DFF, DM}; pg8::StaticOrder<T, 2 * DFF, DM, true> S; S.init(bid, SLAB, CNT + ph * 256);
                EpiSwiglu E{HID, SS}; pg8::gemm_phase(lds, g, S, E);
                if (bid >= 176) cache_copy_part(P, 2 * l + f, bid - 176, 80); }
            SEAM();
            if (RUN) { pg8::Gemm g{HID, (const bf16_t*)(wl + (f ? WO7 : WO2)), T, DM, DFF}; pg8::StaticOrder<TP, DM, DFF, false> S; S.init(bid, SLAB, CNT + ph * 256);
                const bool first = (l == 0 && f == 0);
                const bool wxb = !(l == NL - 1 && f == 1);
                EpiResid E{first ? P.in[0] : X, first ? P.in[1] : X + (size_t)TP * DM, X, XB, SS, 0.5f, wxb}; pg8::gemm_phase(lds, g, S, E);
                small_resid(lds, HID + (size_t)TP * DFF, (const bf16_t*)(wl + (f ? WO7 : WO2)), DFF, first ? P.in[1] : X + (size_t)TP * DM, X + (size_t)TP * DM, XB + (size_t)TP * DM, SS + (size_t)TP * 16, 0.5f, wxb); }
            SEAM();
        }
    }
    if (RUN) final_phase(P);
#undef SEAM
#undef RUN
}

constexpr int LDS_BYTES = BG_OFF + 8192;
constexpr int N_PHASES = 1 + NL * 8 + 1;
constexpr int GRID_HOST = pg8::GRID;

extern "C" void kernel_launch(void* const* d_in, const int* in_sizes, int n_in, void* d_out, int out_size, void* d_ws, size_t ws_size, hipStream_t stream) {
    static int grid = 0;
    if (grid == 0) {
        if (n_in != 21 || (size_t)out_size != O_END || ws_size < WS_END) { fprintf(stderr, "kernel_launch: unexpected shapes: n_in %d out %d ws %zu (need %zu)\n", n_in, out_size, ws_size, (size_t)WS_END); grid = -1; return; }
        int dev = 0, cus = 0, per_cu = 0;
        hipGetDevice(&dev); hipDeviceGetAttribute(&cus, hipDeviceAttributeMultiprocessorCount, dev);
        if (hipFuncSetAttribute((const void*)fwd_megakernel, hipFuncAttributeMaxDynamicSharedMemorySize, LDS_BYTES) != hipSuccess) { fprintf(stderr, "kernel_launch: hipFuncSetAttribute failed\n"); grid = -1; return; }
        if (hipOccupancyMaxActiveBlocksPerMultiprocessor(&per_cu, (const void*)fwd_megakernel, NTHR, LDS_BYTES) != hipSuccess || per_cu < 1) per_cu = 1;
        (void)hipGetLastError();
        if (cus * per_cu < GRID_HOST) fprintf(stderr, "kernel_launch: device admits %d workgroups, kernel needs %d\n", cus * per_cu, GRID_HOST);
        grid = GRID_HOST;
        fprintf(stderr, "kernel_launch: grid %d (cus %d x %d)\n", grid, cus, per_cu);
    }
    if (grid < 0) return;
    Params p{};
    for (int i = 0; i < 21; ++i) p.in[i] = (const float*)d_in[i];
    p.out = (float*)d_out; p.ws = (unsigned char*)d_ws;
    int lo = 0, hi = N_PHASES;
    void* args[] = {&p, &lo, &hi};
    hipError_t e = hipLaunchCooperativeKernel((const void*)fwd_megakernel, dim3(grid), dim3(NTHR), args, LDS_BYTES, stream);
    if (e != hipSuccess) fprintf(stderr, "kernel_launch: cooperative launch failed: %s (grid %d)\n", hipGetErrorString(e), grid);
}
```

```cpp
#include <hip/hip_runtime.h>
#include <hip/hip_cooperative_groups.h>
#include <cstdio>
namespace cg = cooperative_groups;

#define LAS __attribute__((address_space(3)))
#define DI __device__ __forceinline__
typedef unsigned short bf16_t;
typedef short bf16x8 __attribute__((ext_vector_type(8)));
typedef short s16x4 __attribute__((ext_vector_type(4)));
typedef float f32x2 __attribute__((ext_vector_type(2)));
typedef float f32x4 __attribute__((ext_vector_type(4)));
typedef float f32x16 __attribute__((ext_vector_type(16)));
typedef unsigned u32x2 __attribute__((ext_vector_type(2)));
typedef unsigned u32x4 __attribute__((ext_vector_type(4)));
typedef __bf16 hbf2 __attribute__((ext_vector_type(2)));

constexpr int TP = 32768, TS = 2048, T = TP + TS, DM = 1024, DFF = 2816, DIN = 4352, NL = 2;
constexpr int NTHR = 512;
constexpr float EPS = 1e-5f;
constexpr float LOG2E = 1.4426950408889634f;
constexpr float QSCALE = 0.125f * LOG2E;

constexpr size_t W1_B = (size_t)2 * DFF * DM * 2, W2_B = (size_t)DM * DFF * 2, W3_B = (size_t)DIN * DM * 2, W4_B = (size_t)2048 * 512 * 2, W5_B = (size_t)DM * DM * 2;
constexpr size_t WO1 = 0, WO2 = WO1 + W1_B, WO3 = WO2 + W2_B, WO4 = WO3 + W3_B, WO5 = WO4 + W4_B, WO6 = WO5 + W5_B, WO7 = WO6 + W1_B, WL_B = WO7 + W2_B;
constexpr size_t WS_W = 0;
constexpr size_t WS_XB = WS_W + NL * WL_B;
constexpr size_t WS_REG = WS_XB + (size_t)T * DM * 2;
constexpr size_t REG_QA = 0, REG_QB = (size_t)T * 512 * 2, REG_MB = 0, REG_GATES = (size_t)T * DM * 2;
constexpr size_t REG_B = (size_t)T * DM * 2 + (size_t)T * 2048 * 2;
constexpr size_t WS_KA = WS_REG + REG_B, WS_VA = WS_KA + (size_t)T * 128 * 2, WS_KB = WS_VA + (size_t)T * 128 * 2, WS_VB = WS_KB + (size_t)T * 512 * 2;
constexpr size_t WS_SS = WS_VB + (size_t)T * 512 * 2;
constexpr size_t WS_ROPE = WS_SS + (size_t)T * 16 * 4;
constexpr size_t WS_BAR = WS_ROPE + (size_t)8256 * 16 * 4;
constexpr size_t WS_CNT = WS_BAR + 16384;
constexpr size_t WS_SLAB = WS_CNT + 18 * 256 * 4;
constexpr size_t WS_END = WS_SLAB + 4096;
static_assert((size_t)T * DFF * 2 <= REG_B, "hidden fits the region");

constexpr size_t O_Y = 0, O_KWP = (size_t)T * DM, O_VWP = O_KWP + 131072, O_KBP = O_VWP + 131072, O_VBP = O_KBP + 2097152,
                 O_KWS = O_VBP + 2097152, O_VWS = O_KWS + 1048576, O_KBS = O_VWS + 1048576, O_VBS = O_KBS + 16777216, O_END = O_VBS + 16777216;

struct Params { const float* in[21]; float* out; unsigned char* ws; };

DI unsigned pk2(float lo, float hi) { f32x2 v = {lo, hi}; hbf2 r = __builtin_convertvector(v, hbf2); return __builtin_bit_cast(unsigned, r); }
DI float fast_exp2(float x) { return __builtin_amdgcn_exp2f(x); }
DI float fast_rcp(float x) { return __builtin_amdgcn_rcpf(x); }

constexpr int BG_OFF = 8 * 128 * 64 * 2 + 64 + 12 * 1024;
constexpr int RS_NTAB = 12, RS_OFF = 8 * 128 * 64 * 2 + 64;
DI float row_rs_g(const float* SS, int row) {
    const f32x4* p = (const f32x4*)(SS + (size_t)row * 16);
    const f32x4 a = p[0], b = p[1], c = p[2], d = p[3];
    const float s = ((a[0] + a[1]) + (a[2] + a[3])) + ((b[0] + b[1]) + (b[2] + b[3])) + ((c[0] + c[1]) + (c[2] + c[3])) + ((d[0] + d[1]) + (d[2] + d[3]));
    return rsqrtf(s * (1.0f / 1024.0f) + 1e-5f);
}
namespace pg8 {
constexpr int BM = 256, BK = 64, HALF = 128, HTB = HALF * BK * 2, STAGE_BYTES = 8 * HTB, NXCD = 8, WGM = 8;
DI int lds_byte(int r, int c) { const int st = (r >> 4) * 2 + (c >> 5), rr = r & 15, cc = c & 31, ob = rr * 64 + cc * 2; return st * 1024 + (ob ^ (((ob >> 9) & 1) << 5)); }
DI void stage_rc(int b, int& R, int& C) { const int st = b / 1024, sb = b % 1024, swz = sb ^ (((sb >> 9) & 1) << 5); R = (st >> 1) * 16 + swz / 64; C = (st & 1) * 32 + (swz % 64) / 2; }
DI int perm32(int rho) { const int n = rho >> 4, i = rho & 15; return 8 * (i >> 2) + 4 * n + (i & 3); }
struct Unit { int pm, pn, kt0, nkt, part, tt, rk; };
struct Gemm { const bf16_t* A; const bf16_t* Bt; int M, N, K; };
constexpr int MAXP = 6;
constexpr int GRID = 256;
template <int M_, int N_, int K_, bool SPLIT, int TAIL = 0>
struct StaticOrder {
    static constexpr int nM = M_ / BM, nN = N_ / BM, nwg = nM * nN, G = GRID, nt = K_ / BK, nfull = nwg / G, rem = nwg % G;
    static constexpr int pmax = (rem > 0 && SPLIT) ? (G / rem < MAXP ? G / rem : MAXP) : 1;
    static constexpr int nparts = pmax < 2 ? 1 : (pmax > nt / 4 ? (nt / 4 < 2 ? 1 : nt / 4) : pmax);
    static constexpr int nrm = TAIL == 0 ? nwg : nfull * G;
    int c; float* slab; unsigned* cnt;
    DI void init(int c_, float* slab_, unsigned* cnt_) { c = c_; slab = slab_; cnt = cnt_; }
    static DI void decode(int L, Unit& u) {
        int wgid = L;
        if (L < nrm) { constexpr int q = nrm / NXCD, r = nrm % NXCD; const int xcd = wgid % NXCD, off = wgid / NXCD; wgid = (xcd < r ? xcd * (q + 1) : r * (q + 1) + (xcd - r) * q) + off; }
        constexpr int nig = WGM * nN; const int gid = wgid / nig, fm = gid * WGM, gsz = (nM - fm) < WGM ? (nM - fm) : WGM;
        u.pm = fm + ((wgid % nig) % gsz); u.pn = (wgid % nig) / gsz;
    }
    DI bool next(int i, Unit& u) const {
        u.kt0 = 0; u.nkt = nt; u.part = -1; u.tt = 0; u.rk = 0;
        if (TAIL == 2) { if (i > 0 || c >= rem) return false; decode(nfull * G + c, u); return true; }
        if (i < nfull) { decode(i * G + c, u); return true; }
        if (TAIL == 1 || i > nfull) return false;
        if (nparts == 1) { if (c >= rem) return false; decode(nfull * G + c, u); return true; }
        if (c >= rem * nparts) return false;
        constexpr int remd = rem > 0 ? rem : 1, pairs = nt / 2, base = pairs / nparts, extra = pairs % nparts;
        const int tt = c % remd, part = c / remd;
        decode(nfull * G + tt, u); u.tt = tt; u.part = part;
        u.kt0 = 2 * (part * base + (part < extra ? part : extra)); u.nkt = 2 * (base + (part < extra ? 1 : 0));
        return true;
    }
};
struct MergeOrder {
    StaticOrder<TP, DM, 512, false> so; static constexpr int nparts = 1; float* slab; unsigned* cnt;
    DI bool next(int i, Unit& u) const { Unit p; if (!so.next(i >> 1, p)) return false; const int s = i & 1; u = p; u.pm = s * (T / BM) + p.pm; u.pn = s * 4 + p.pn; return true; }
};

template <class Epi, class Sched>
DI void gemm_phase(LAS unsigned char* lds, const Gemm g, const Sched& S, const Epi& E) {
    int tid_ = threadIdx.x; asm volatile("" : "+v"(tid_));
    const int tid = tid_, wid = __builtin_amdgcn_readfirstlane(tid >> 6), lane = tid & 63, wr = wid >> 2, wc = wid & 3, fr = lane & 15, fq = lane >> 4;
    const int K = g.K;
    unsigned voffA[2], voffB[2];
#pragma unroll
    for (int i = 0; i < 2; ++i) { int R, C; stage_rc(tid * 16 + i * 8192, R, C); const int Rb = Epi::PERM ? ((R & ~31) + perm32(R & 31)) : R;
        voffA[i] = (unsigned)(R * K + C) * 2u; voffB[i] = (unsigned)(Rb * K + C) * 2u; }
    const size_t kstep = (size_t)(BK * 2);
    const size_t hstep = (size_t)HALF * K * 2;
    const size_t tstep = 2 * hstep;
    const unsigned ldsw = (unsigned)wid * 1024u;
    const int aoff = lds_byte(wr * 64 + fr, fq * 8), boff = lds_byte(wc * 32 + fr, fq * 8);
#define PG8_SA(b, h) (((b) * 2 + (h)) * HTB)
#define PG8_SB(b, h) ((4 + (b) * 2 + (h)) * HTB)
#define PG8_STAGE(bufoff, gbase, voff) do { _Pragma("unroll") for (int _i = 0; _i < 2; ++_i) \
        __builtin_amdgcn_global_load_lds((const unsigned*)((const char*)(gbase) + (voff)[_i]), (LAS unsigned*)(lds + (bufoff) + ldsw + _i * 8192), 16, 0, 0); } while (0)
#define PG8_LDA(dst, b, h) do { _Pragma("unroll") for (int m = 0; m < 4; ++m) _Pragma("unroll") for (int k = 0; k < 2; ++k) dst[m][k] = *(const LAS bf16x8*)(lds + PG8_SA(b, h) + aoff + m * 2048 + k * 1024); } while (0)
#define PG8_LDB(dst, b, h) do { _Pragma("unroll") for (int n = 0; n < 2; ++n) _Pragma("unroll") for (int k = 0; k < 2; ++k) dst[n][k] = *(const LAS bf16x8*)(lds + PG8_SB(b, h) + boff + n * 2048 + k * 1024); } while (0)
#define PG8_MMA(ai, bj, At, Bt) do { __builtin_amdgcn_s_setprio(1); _Pragma("unroll") for (int m = 0; m < 4; ++m) _Pragma("unroll") for (int n = 0; n < 2; ++n) _Pragma("unroll") for (int k = 0; k < 2; ++k) \
        acc[ai][bj][m][n] = __builtin_amdgcn_mfma_f32_16x16x32_bf16(Bt[n][k], At[m][k], acc[ai][bj][m][n], 0, 0, 0); __builtin_amdgcn_s_setprio(0); } while (0)
#define PG8_WAIT_V(n) asm volatile("s_waitcnt vmcnt(" #n ")" ::: "memory")
#define PG8_WAIT_L(n) asm volatile("s_waitcnt lgkmcnt(" #n ")" ::: "memory")
#define PG8_BAR __builtin_amdgcn_s_barrier()
#define PG8_SCHED __builtin_amdgcn_sched_barrier(0)
    Unit cur, nxt; int ui = 0;
    if (!S.next(0, cur)) return;
    if constexpr (Epi::USES_RS) {
        LAS float* tab = (LAS float*)(lds + RS_OFF);
        int k = 0, lastpm = -1; Unit tu;
        for (int i = 0; S.next(i, tu); ++i) {
            if (tu.pm != lastpm) { if ((k & 1) == (tid >> 8) && k < RS_NTAB) tab[k * 256 + (tid & 255)] = row_rs_g(E.ss(), tu.pm * 256 + (tid & 255)); ++k; lastpm = tu.pm; }
        }
        E.phase_init(lds, tid);
        __syncthreads();
    }
    f32x4 acc[2][2][4][2];
#pragma unroll
    for (int a = 0; a < 2; ++a)
#pragma unroll
        for (int b = 0; b < 2; ++b)
#pragma unroll
            for (int m = 0; m < 4; ++m)
#pragma unroll
                for (int n = 0; n < 2; ++n) acc[a][b][m][n] = (f32x4){0.f, 0.f, 0.f, 0.f};
    bf16x8 At[4][2], B0[2][2], B1[2][2];
    const char* cA = (const char*)g.A + (size_t)cur.pm * tstep + (size_t)cur.kt0 * kstep; const char* cB = (const char*)g.Bt + (size_t)cur.pn * tstep + (size_t)cur.kt0 * kstep;
    PG8_STAGE(PG8_SB(0, 0), cB, voffB); PG8_STAGE(PG8_SA(0, 0), cA, voffA); PG8_STAGE(PG8_SB(0, 1), cB + hstep, voffB); PG8_STAGE(PG8_SA(0, 1), cA + hstep, voffA);
    if (wr == 1) PG8_BAR;
    PG8_WAIT_V(4); PG8_BAR;
    PG8_STAGE(PG8_SB(1, 0), cB + kstep, voffB); PG8_STAGE(PG8_SA(1, 0), cA + kstep, voffA); PG8_STAGE(PG8_SB(1, 1), cB + hstep + kstep, voffB);
    PG8_WAIT_V(6); PG8_BAR;
    for (;;) {
        const bool has_next = S.next(ui + 1, nxt);
        const char* nA = has_next ? (const char*)g.A + (size_t)nxt.pm * tstep + (size_t)nxt.kt0 * kstep : cA; const char* nB = has_next ? (const char*)g.Bt + (size_t)nxt.pn * tstep + (size_t)nxt.kt0 * kstep : cB;
        const int nt = cur.nkt;
        for (int t = 0; t < nt; t += 2) {
            const bool last = (t == nt - 2);
            const char* a1 = cA + (size_t)(t + 1) * kstep;
            const char* a2 = last ? nA : cA + (size_t)(t + 2) * kstep; const char* b2 = last ? nB : cB + (size_t)(t + 2) * kstep;
            const char* a3 = a2 + kstep; const char* b3 = b2 + kstep;
            PG8_LDB(B0, 0, 0); PG8_SCHED; PG8_LDA(At, 0, 0); PG8_STAGE(PG8_SA(1, 1), a1 + hstep, voffA);
            PG8_WAIT_L(8); PG8_BAR; PG8_WAIT_L(0); PG8_MMA(0, 0, At, B0); PG8_BAR; PG8_SCHED;
            PG8_LDB(B1, 0, 1); PG8_STAGE(PG8_SB(0, 0), b2, voffB);
            PG8_BAR; PG8_WAIT_L(0); PG8_MMA(0, 1, At, B1); PG8_BAR;
            PG8_LDA(At, 0, 1); PG8_STAGE(PG8_SA(0, 0), a2, voffA);
            PG8_BAR; PG8_WAIT_L(0); PG8_MMA(1, 0, At, B0); PG8_BAR; PG8_SCHED;
            PG8_STAGE(PG8_SB(0, 1), b2 + hstep, voffB);
            PG8_WAIT_V(6); PG8_BAR; PG8_MMA(1, 1, At, B1); PG8_BAR;
            PG8_LDB(B0, 1, 0); PG8_SCHED; PG8_LDA(At, 1, 0); PG8_STAGE(PG8_SA(0, 1), a2 + hstep, voffA);
            PG8_WAIT_L(8); PG8_BAR; PG8_WAIT_L(0); PG8_MMA(0, 0, At, B0); PG8_BAR; PG8_SCHED;
            PG8_LDB(B1, 1, 1); PG8_STAGE(PG8_SB(1, 0), b3, voffB);
            PG8_BAR; PG8_WAIT_L(0); PG8_MMA(0, 1, At, B1); PG8_BAR;
            PG8_LDA(At, 1, 1); PG8_STAGE(PG8_SA(1, 0), a3, voffA);
            PG8_BAR; PG8_WAIT_L(0); PG8_MMA(1, 0, At, B0); PG8_BAR; PG8_SCHED;
            PG8_STAGE(PG8_SB(1, 1), b3 + hstep, voffB);
            PG8_WAIT_V(6); PG8_BAR; PG8_MMA(1, 1, At, B1); PG8_BAR;
        }
        if (cur.part < 0) E(acc, cur, wr, wc, fr, fq, lds);
        if (!has_next) break;
        if (!E.keep(cur)) {
#pragma unroll
            for (int a = 0; a < 2; ++a)
#pragma unroll
                for (int b = 0; b < 2; ++b)
#pragma unroll
                    for (int m = 0; m < 4; ++m)
#pragma unroll
                        for (int n = 0; n < 2; ++n) acc[a][b][m][n] = (f32x4){0.f, 0.f, 0.f, 0.f};
        }
        nxt.rk = cur.rk + (nxt.pm != cur.pm ? 1 : 0);
        cur = nxt; cA = nA; cB = nB; ++ui;
    }
    PG8_WAIT_V(0);
    if (wr == 0) PG8_BAR;
    PG8_BAR;
    {
      if (Sched::nparts > 1 && cur.part >= 0) {
        constexpr int np = Sched::nparts;
        float* sl = S.slab + (size_t)(cur.tt * np) * 65536 + (size_t)tid * 4;
        { float* mine = sl + (size_t)cur.part * 65536;
#pragma unroll
          for (int a = 0; a < 2; ++a)
#pragma unroll
            for (int b = 0; b < 2; ++b)
#pragma unroll
                for (int m = 0; m < 4; ++m)
#pragma unroll
                    for (int n = 0; n < 2; ++n) *(f32x4*)(mine + (size_t)(((a * 2 + b) * 4 + m) * 2 + n) * 2048) = acc[a][b][m][n]; }
        asm volatile("s_waitcnt vmcnt(0)" ::: "memory");
        __syncthreads();
        volatile LAS unsigned* flag = (volatile LAS unsigned*)(lds + STAGE_BYTES + 8);
        if (tid == 0) {
            __builtin_amdgcn_fence(__ATOMIC_RELEASE, "agent");
            asm volatile("s_waitcnt vmcnt(0)" ::: "memory");
            const unsigned old = __hip_atomic_fetch_add(S.cnt + cur.tt, 1u, __ATOMIC_RELAXED, __HIP_MEMORY_SCOPE_AGENT);
            if (old == (unsigned)(np - 1)) { __builtin_amdgcn_fence(__ATOMIC_ACQUIRE, "agent"); asm volatile("s_waitcnt vmcnt(0)" ::: "memory"); }
            flag[0] = old;
        }
        __syncthreads();
        const unsigned old = flag[0];
        if (old == (unsigned)(np - 1)) {
            for (int p = 0; p < np; ++p) {
                if (p == cur.part) continue;
                const float* oth = sl + (size_t)p * 65536;
#pragma unroll
                for (int a = 0; a < 2; ++a)
#pragma unroll
                    for (int b = 0; b < 2; ++b) {
#pragma unroll
                        for (int m = 0; m < 4; ++m)
#pragma unroll
                            for (int n = 0; n < 2; ++n) acc[a][b][m][n] += *(const f32x4*)(oth + (size_t)(((a * 2 + b) * 4 + m) * 2 + n) * 2048);
                        asm volatile("" ::: "memory");
                    }
            }
            E(acc, cur, wr, wc, fr, fq, lds);
        }
        __syncthreads();
      }
    }
#undef PG8_SA
#undef PG8_SB
#undef PG8_STAGE
#undef PG8_LDA
#undef PG8_LDB
#undef PG8_MMA
#undef PG8_WAIT_V
#undef PG8_WAIT_L
#undef PG8_BAR
#undef PG8_SCHED
}
}
using pg8::Unit;

DI float row_rs(const float* SS, int row) {
    const f32x4* p = (const f32x4*)(SS + (size_t)row * 16);
    const f32x4 a = p[0], b = p[1], c = p[2], d = p[3];
    const float s = ((a[0] + a[1]) + (a[2] + a[3])) + ((b[0] + b[1]) + (b[2] + b[3])) + ((c[0] + c[1]) + (c[2] + c[3])) + ((d[0] + d[1]) + (d[2] + d[3]));
    return rsqrtf(s * (1.0f / 1024.0f) + EPS);
}
DI float row_rs4(const float* SS, int row, int fq) {
    const f32x4 a = *(const f32x4*)(SS + (size_t)row * 16 + 4 * fq);
    float s = (a[0] + a[1]) + (a[2] + a[3]);
    s += __shfl_xor(s, 16); s += __shfl_xor(s, 32);
    return rsqrtf(s * (1.0f / 1024.0f) + EPS);
}
DI float silu_mul(float a, float b) { return a * fast_rcp(1.0f + fast_exp2(-a * LOG2E)) * b; }
DI float sigmoidf_(float a) { return fast_rcp(1.0f + fast_exp2(-a * LOG2E)); }

struct EpiSwiglu {
    static constexpr bool PERM = true, USES_RS = true;
    bf16_t* H; const float* SS;
    DI const float* ss() const { return SS; }
    DI void phase_init(LAS unsigned char*, int) const {}
    DI bool keep(const Unit&) const { return false; }
    DI void operator()(f32x4 (&acc)[2][2][4][2], const Unit& u, int wr, int wc, int fr, int fq, LAS unsigned char* lds) const {
        const int row0 = u.pm * 256 + wr * 64 + fr, hc = u.pn * 128 + wc * 32 + 8 * fq;
        float rsv[8];
        { const LAS float* tab = (const LAS float*)(lds + RS_OFF) + u.rk * 256 + wr * 64 + fr;
#pragma unroll
          for (int i = 0; i < 8; ++i) rsv[i] = tab[(i >> 2) * 128 + (i & 3) * 16]; }
#pragma unroll
        for (int ai = 0; ai < 2; ++ai)
#pragma unroll
            for (int m = 0; m < 4; ++m) {
                const int row = row0 + ai * 128 + m * 16; const float rs = rsv[ai * 4 + m];
                const f32x4 a0 = acc[ai][0][m][0] * rs, a1 = acc[ai][0][m][1] * rs, b0 = acc[ai][1][m][0] * rs, b1 = acc[ai][1][m][1] * rs;
                u32x4 w;
                w.x = pk2(silu_mul(a0[0], b0[0]), silu_mul(a0[1], b0[1])); w.y = pk2(silu_mul(a0[2], b0[2]), silu_mul(a0[3], b0[3]));
                w.z = pk2(silu_mul(a1[0], b1[0]), silu_mul(a1[1], b1[1])); w.w = pk2(silu_mul(a1[2], b1[2]), silu_mul(a1[3], b1[3]));
                *(u32x4*)(H + (size_t)row * DFF + hc) = w;
            }
    }
};

struct EpiResid {
    static constexpr bool PERM = false, USES_RS = false;
    const float* xin_p; const float* xin_s; float* X; bf16_t* XB; float* SS; float scale; bool wxb;
    DI bool keep(const Unit&) const { return false; }
    DI void operator()(f32x4 (&acc)[2][2][4][2], const Unit& u, int wr, int wc, int fr, int fq, LAS unsigned char* lds) const {
        const int row0 = u.pm * 256 + wr * 64 + fr, col0 = u.pn * 256 + wc * 32 + 4 * fq;
#pragma unroll
        for (int ai = 0; ai < 2; ++ai) {
            f32x4 xv[4][2][2];
#pragma unroll
            for (int m = 0; m < 4; ++m) {
                const int row = row0 + ai * 128 + m * 16;
                const float* xi = (row < TP ? xin_p + (size_t)row * DM : xin_s + (size_t)(row - TP) * DM) + col0;
#pragma unroll
                for (int bj = 0; bj < 2; ++bj)
#pragma unroll
                    for (int n = 0; n < 2; ++n) xv[m][bj][n] = *(const f32x4*)(xi + bj * 128 + n * 16);
            }
#pragma unroll
            for (int m = 0; m < 4; ++m) {
                const int row = row0 + ai * 128 + m * 16;
                float* xo = X + (size_t)row * DM + col0; bf16_t* xb = XB + (size_t)row * DM + col0;
                float ssq = 0.f;
#pragma unroll
                for (int bj = 0; bj < 2; ++bj)
#pragma unroll
                    for (int n = 0; n < 2; ++n) {
                        const int c = bj * 128 + n * 16;
                        const f32x4 o = xv[m][bj][n] + acc[ai][bj][m][n] * scale;
                        *(f32x4*)(xo + c) = o;
                        if (wxb) { u32x2 w; w.x = pk2(o[0], o[1]); w.y = pk2(o[2], o[3]); *(u32x2*)(xb + c) = w; }
                        ssq += (o[0] * o[0] + o[1] * o[1]) + (o[2] * o[2] + o[3] * o[3]);
                    }
                ssq += __shfl_xor(ssq, 16); ssq += __shfl_xor(ssq, 32);
                if (fq == 0) SS[(size_t)row * 16 + u.pn * 4 + wc] = ssq;
            }
        }
    }
};

struct EpiProj {
    static constexpr bool PERM = true, USES_RS = true;
    DI const float* ss() const { return (const float*)(ws + WS_SS); }
    DI void phase_init(LAS unsigned char* lds, int tid) const { *(LAS f32x4*)(lds + BG_OFF + tid * 16) = *(const f32x4*)(bgate + tid * 4); }
    unsigned char* ws; const float* bgate; float* out; int layer;
    DI bool keep(const Unit&) const { return false; }
    DI void operator()(f32x4 (&acc)[2][2][4][2], const Unit& u, int wr, int wc, int fr, int fq, LAS unsigned char* lds) const {
        bf16_t* const QA = (bf16_t*)(ws + WS_REG + REG_QA); bf16_t* const QB = (bf16_t*)(ws + WS_REG + REG_QB); bf16_t* const GATES = (bf16_t*)(ws + WS_REG + REG_GATES);
        bf16_t* const KA = (bf16_t*)(ws + WS_KA); bf16_t* const VA = (bf16_t*)(ws + WS_VA); bf16_t* const KB = (bf16_t*)(ws + WS_KB); bf16_t* const VB = (bf16_t*)(ws + WS_VB);
        const float* const ROPE = (const float*)(ws + WS_ROPE);
        const int row0 = u.pm * 256 + wr * 64 + fr, cw = wc * 32 + 8 * fq;
        const bool rope_wave = (wc & 1) == 0;
        float rsv[8];
        { const LAS float* tab = (const LAS float*)(lds + RS_OFF) + u.rk * 256 + wr * 64 + fr;
#pragma unroll
          for (int i = 0; i < 8; ++i) rsv[i] = tab[(i >> 2) * 128 + (i & 3) * 16]; }
#pragma unroll
        for (int ai = 0; ai < 2; ++ai)
#pragma unroll
            for (int m = 0; m < 4; ++m) {
                const int row = row0 + ai * 128 + m * 16; const float rs = rsv[ai * 4 + m];
                int posidx; long offA, offB;
                const bool prm = row < TP;
                if (prm) { const int b = row >> 13, t = row & 8191; posidx = t;
                    offA = t >= 8064 ? ((long)(layer * 4 + b) * 128 + (t - 8064)) * 128 : -1;
                    offB = t >= 7680 ? ((long)(layer * 4 + b) * 512 + (t - 7680)) * 512 : -1;
                } else { const int sb = (row - TP) >> 6, t = (row - TP) & 63; posidx = 8192 + t;
                    offA = ((long)(layer * 32 + sb) * 128 + 64 + t) * 128;
                    offB = ((long)(layer * 32 + sb) * 512 + 448 + t) * 512; }
#pragma unroll
                for (int bj = 0; bj < 2; ++bj) {
                    const int gcol = u.pn * 256 + bj * 128;
                    f32x4 v0 = acc[ai][bj][m][0] * rs, v1 = acc[ai][bj][m][1] * rs;
                    if (gcol < 768 && gcol != 640) {
                        if (rope_wave) {
                            const float* rp = ROPE + (size_t)posidx * 16;
                            const f32x4 cs0 = *(const f32x4*)rp, cs1 = *(const f32x4*)(rp + 4), sn0 = *(const f32x4*)(rp + 8), sn1 = *(const f32x4*)(rp + 12);
                            f32x4 p0, p1;
#pragma unroll
                            for (int j = 0; j < 4; ++j) { p0[j] = __shfl_xor(v0[j], 16); p1[j] = __shfl_xor(v1[j], 16); }
                            if (fq == 0) { v0 = v0 * cs0 - p0 * sn0; v1 = v1 * cs1 - p1 * sn1; }
                            else if (fq == 1) { v0 = v0 * cs0 + p0 * sn0; v1 = v1 * cs1 + p1 * sn1; }
                        }
                    }
                    bf16_t* dst; int ld, c0; float* of = nullptr; long orow = -1;
                    if (gcol < 512) { dst = QA; ld = 512; c0 = gcol; v0 = v0 * QSCALE; v1 = v1 * QSCALE; }
                    else if (gcol < 640) { dst = KA; ld = 128; c0 = gcol - 512; of = out + (prm ? O_KWP : O_KWS); orow = offA; }
                    else if (gcol < 768) { dst = VA; ld = 128; c0 = gcol - 640; of = out + (prm ? O_VWP : O_VWS); orow = offA; }
                    else if (gcol < 1280) { dst = QB; ld = 512; c0 = gcol - 768; v0 = v0 * QSCALE; v1 = v1 * QSCALE; }
                    else if (gcol < 1792) { dst = KB; ld = 512; c0 = gcol - 1280; of = out + (prm ? O_KBP : O_KBS); orow = offB; }
                    else if (gcol < 2304) { dst = VB; ld = 512; c0 = gcol - 1792; of = out + (prm ? O_VBP : O_VBS); orow = offB; }
                    else { dst = GATES; ld = 2048; c0 = gcol - 2304;
                        const f32x4 g0 = *(const LAS f32x4*)(lds + BG_OFF + (c0 + cw) * 4), g1 = *(const LAS f32x4*)(lds + BG_OFF + (c0 + cw + 4) * 4);
#pragma unroll
                        for (int j = 0; j < 4; ++j) { v0[j] = sigmoidf_(v0[j] + g0[j]); v1[j] = sigmoidf_(v1[j] + g1[j]); } }
                    u32x4 w; w.x = pk2(v0[0], v0[1]); w.y = pk2(v0[2], v0[3]); w.z = pk2(v1[0], v1[1]); w.w = pk2(v1[2], v1[3]);
                    *(u32x4*)(dst + (size_t)row * ld + c0 + cw) = w;
                    if (of != nullptr && orow >= 0) { float* op = of + orow + c0 + cw; *(f32x4*)op = v0; *(f32x4*)(op + 4) = v1; }
                }
            }
    }
};

struct EpiMerge {
    static constexpr bool PERM = true, USES_RS = false;
    const bf16_t* GATES; bf16_t* MB;
    DI bool keep(const Unit& u) const { return u.pm < T / 256; }
    DI void operator()(f32x4 (&acc)[2][2][4][2], const Unit& u, int wr, int wc, int fr, int fq, LAS unsigned char* lds) const {
        const int s = u.pm >= T / 256 ? 1 : 0;
        const int row0 = (u.pm - s * (T / 256)) * 256 + wr * 64 + fr, col0 = (u.pn - s * 4) * 256 + wc * 32 + 8 * fq;
#pragma unroll
        for (int ai = 0; ai < 2; ++ai) {
            u32x4 gbv[4][2], gav[4][2];
#pragma unroll
            for (int m = 0; m < 4; ++m) {
                const bf16_t* gp = GATES + (size_t)(row0 + ai * 128 + m * 16) * 2048 + col0;
#pragma unroll
                for (int bj = 0; bj < 2; ++bj) { gbv[m][bj] = *(const u32x4*)(gp + 1024 + bj * 128); if (s == 0) gav[m][bj] = *(const u32x4*)(gp + bj * 128); }
            }
#pragma unroll
            for (int m = 0; m < 4; ++m) {
                const int row = row0 + ai * 128 + m * 16;
#pragma unroll
                for (int bj = 0; bj < 2; ++bj) {
                    const u32x4 gb = gbv[m][bj];
                    float gbf[8];
#pragma unroll
                    for (int q = 0; q < 4; ++q) { gbf[2 * q] = __uint_as_float(gb[q] << 16); gbf[2 * q + 1] = __uint_as_float(gb[q] & 0xffff0000u); }
                    if (s == 0) {
                        const u32x4 ga = gav[m][bj];
#pragma unroll
                        for (int q = 0; q < 4; ++q) {
                            const float a0 = __uint_as_float(ga[q] << 16), a1 = __uint_as_float(ga[q] & 0xffff0000u);
                            const int n = q >> 1, j = (q & 1) * 2;
                            acc[ai][bj][m][n][j] *= a0 * fast_rcp(gbf[2 * q]); acc[ai][bj][m][n][j + 1] *= a1 * fast_rcp(gbf[2 * q + 1]);
                        }
                    } else {
                        u32x4 w;
#pragma unroll
                        for (int q = 0; q < 4; ++q) { const int n = q >> 1, j = (q & 1) * 2; w[q] = pk2(acc[ai][bj][m][n][j] * gbf[2 * q], acc[ai][bj][m][n][j + 1] * gbf[2 * q + 1]); }
                        *(u32x4*)(MB + (size_t)row * DM + col0 + bj * 128) = w;
                    }
                }
            }
        }
    }
};

constexpr int SM_STAGE = 24576, SM_NST = 5, SM_PART = SM_NST * SM_STAGE;
DI void small_kloop(LAS unsigned char* lds, f32x16& acc, const bf16_t* Ap, const bf16_t* Bp, int K, int nkt, int tid, int wm, int wn, int ql, int h) {
    const int wv = tid >> 6, l = tid & 63, r8 = l >> 3, p = l & 7;
    const char* ga = (const char*)(Ap + (size_t)(8 * wv + r8) * K) + ((p ^ r8) << 4);
    const char* gb0 = (const char*)(Bp + (size_t)(8 * wv + r8) * K) + ((p ^ r8) << 4);
    const char* gb1 = (const char*)(Bp + (size_t)(64 + 8 * wv + r8) * K) + ((p ^ r8) << 4);
    const unsigned la = (unsigned)wv * 1024u, lb0 = 8192u + (unsigned)wv * 1024u, lb1 = 8192u + 8192u + (unsigned)wv * 1024u;
#define SM_ISSUE(kt_, slot_) do { const int _k = (kt_) < nkt ? (kt_) : nkt - 1; LAS unsigned char* _st = lds + (slot_) * SM_STAGE; \
        __builtin_amdgcn_global_load_lds((const unsigned*)(ga + (size_t)_k * 128), (LAS unsigned*)(_st + la), 16, 0, 0); \
        __builtin_amdgcn_global_load_lds((const unsigned*)(gb0 + (size_t)_k * 128), (LAS unsigned*)(_st + lb0), 16, 0, 0); \
        __builtin_amdgcn_global_load_lds((const unsigned*)(gb1 + (size_t)_k * 128), (LAS unsigned*)(_st + lb1), 16, 0, 0); } while (0)
    __syncthreads();
    SM_ISSUE(0, 0); SM_ISSUE(1, 1); SM_ISSUE(2, 2); SM_ISSUE(3, 3);
    const int ra = 32 * wm + ql, rb = 32 * wn + ql;
    const unsigned aoff = (unsigned)ra * 128u, boff = 8192u + (unsigned)rb * 128u, sa = (unsigned)(ra & 7), sb = (unsigned)(rb & 7);
    int slot = 0, islot = 4;
#pragma nounroll
    for (int kt = 0; kt < nkt; ++kt) {
        asm volatile("s_waitcnt vmcnt(9)" ::: "memory");
        __builtin_amdgcn_s_barrier();
        asm volatile("" ::: "memory");
        SM_ISSUE(kt + 4, islot);
        const LAS unsigned char* st = lds + slot * SM_STAGE;
#pragma unroll
        for (int s = 0; s < 4; ++s) {
            const bf16x8 a = *(const LAS bf16x8*)(st + aoff + (((unsigned)(2 * s + h) ^ sa) << 4));
            const bf16x8 b = *(const LAS bf16x8*)(st + boff + (((unsigned)(2 * s + h) ^ sb) << 4));
            acc = __builtin_amdgcn_mfma_f32_32x32x16_bf16(a, b, acc, 0, 0, 0);
        }
        islot = slot; slot = slot == SM_NST - 1 ? 0 : slot + 1;
    }
    asm volatile("s_waitcnt vmcnt(0)" ::: "memory");
    __builtin_amdgcn_s_barrier();
    asm volatile("" ::: "memory");
#undef SM_ISSUE
}
DI void small_resid(LAS unsigned char* lds, const bf16_t* A, const bf16_t* Bt, int K, const float* xin, float* X, bf16_t* XB, float* SS, float scale, bool wxb = true) {
    int tid_ = threadIdx.x; asm volatile("" : "+v"(tid_));
    const int tid = tid_, wid = __builtin_amdgcn_readfirstlane(tid >> 6), lane = tid & 63, wm = wid >> 2, wn = wid & 3, ql = lane & 31, h = lane >> 5;
    for (int u = blockIdx.x; u < 256; u += gridDim.x) {
        const int tm = u >> 3, tn = u & 7;
        f32x16 acc;
#pragma unroll
        for (int r = 0; r < 16; ++r) acc[r] = 0.f;
        small_kloop(lds, acc, A + (size_t)(tm * 64) * K, Bt + (size_t)(tn * 128) * K, K, K / 64, tid, wm, wn, ql, h);
        LAS float* part = (LAS float*)(lds + SM_PART);
        const int col = tn * 128 + 32 * wn + ql;
#pragma unroll
        for (int r = 0; r < 16; ++r) {
            const int rl = 32 * wm + (r & 3) + 8 * (r >> 2) + 4 * h; const size_t e = (size_t)(tm * 64 + rl) * DM + col;
            const float o = xin[e] + scale * acc[r];
            X[e] = o; if (wxb) XB[e] = (bf16_t)(pk2(o, 0.f) & 0xffffu);
            float q = o * o;
            q += __shfl_xor(q, 1); q += __shfl_xor(q, 2); q += __shfl_xor(q, 4); q += __shfl_xor(q, 8); q += __shfl_xor(q, 16);
            if (ql == 0) part[rl * 4 + wn] = q;
        }
        __syncthreads();
        if (tid < 128) { const int rl = tid >> 1, pr = tid & 1; SS[(size_t)(tm * 64 + rl) * 16 + tn * 2 + pr] = part[rl * 4 + 2 * pr] + part[rl * 4 + 2 * pr + 1]; }
    }
    __syncthreads();
}
DI void small_merge(LAS unsigned char* lds, const bf16_t* YA, const bf16_t* YB, const bf16_t* W4, const bf16_t* GATES, bf16_t* MB) {
    int tid_ = threadIdx.x; asm volatile("" : "+v"(tid_));
    const int tid = tid_, wid = __builtin_amdgcn_readfirstlane(tid >> 6), lane = tid & 63, wm = wid >> 2, wn = wid & 3, ql = lane & 31, h = lane >> 5;
    for (int u = blockIdx.x; u < 256; u += gridDim.x) {
        const int tm = u >> 3, tn = u & 7;
        f32x16 acc, acc2;
#pragma unroll
        for (int r = 0; r < 16; ++r) { acc[r] = 0.f; acc2[r] = 0.f; }
        small_kloop(lds, acc, YA + (size_t)(tm * 64) * 512, W4 + (size_t)(tn * 128) * 512, 512, 8, tid, wm, wn, ql, h);
        small_kloop(lds, acc2, YB + (size_t)(tm * 64) * 512, W4 + (size_t)(1024 + tn * 128) * 512, 512, 8, tid, wm, wn, ql, h);
        const int col = tn * 128 + 32 * wn + ql;
#pragma unroll
        for (int r = 0; r < 16; ++r) {
            const int rl = 32 * wm + (r & 3) + 8 * (r >> 2) + 4 * h; const size_t row = (size_t)(tm * 64 + rl);
            const float ga = __uint_as_float((unsigned)GATES[row * 2048 + col] << 16), gb = __uint_as_float((unsigned)GATES[row * 2048 + 1024 + col] << 16);
            MB[row * DM + col] = (bf16_t)(pk2(ga * acc[r] + gb * acc2[r], 0.f) & 0xffffu);
        }
    }
    __syncthreads();
}

DI void tr_job(LAS float* tile, const float* __restrict__ src, bf16_t* __restrict__ dst, const float* __restrict__ g, int K, int N, int perm, int& tbase) {
    const int G = gridDim.x, nk = K / 64, ntile = nk * (N / 64), tid = threadIdx.x;
    int first = ((int)blockIdx.x - tbase % G) % G; if (first < 0) first += G;
    for (int t = first; t < ntile; t += G) {
        const int tn = t / nk, tk = t % nk; const int nb = tn * 64;
        const int scol = perm ? (((nb & 255) < 128) ? (nb >> 8) * 128 + (nb & 255) : DFF + (nb >> 8) * 128 + (nb & 255) - 128) : nb;
        const int ty = tid >> 4, tx = tid & 15;
#pragma unroll
        for (int i = 0; i < 2; ++i) { const int k = ty + 32 * i; f32x4 v = *(const f32x4*)(src + (size_t)(tk * 64 + k) * N + scol + 4 * tx);
            if (g) v = v * g[tk * 64 + k];
            tile[k * 65 + 4 * tx] = v[0]; tile[k * 65 + 4 * tx + 1] = v[1]; tile[k * 65 + 4 * tx + 2] = v[2]; tile[k * 65 + 4 * tx + 3] = v[3]; }
        __syncthreads();
        { const int n = tid >> 3, kp = tid & 7; float e[8];
#pragma unroll
          for (int j = 0; j < 8; ++j) e[j] = tile[(8 * kp + j) * 65 + n];
          u32x4 w; w.x = pk2(e[0], e[1]); w.y = pk2(e[2], e[3]); w.z = pk2(e[4], e[5]); w.w = pk2(e[6], e[7]);
          *(u32x4*)(dst + (size_t)(nb + n) * K + tk * 64 + 8 * kp) = w; }
        __syncthreads();
    }
    tbase += ntile;
}

DI void sincos_d(double a, float& c, float& s) {
    const double k = rint(a * 0.63661977236758134308);
    const double r = (a - k * 1.57079632679489655800) - k * 6.12323399573676603587e-17;
    const double r2 = r * r;
    const double sp = r * (1.0 + r2 * (-1.0 / 6 + r2 * (1.0 / 120 + r2 * (-1.0 / 5040 + r2 * (1.0 / 362880 + r2 * (-1.0 / 39916800 + r2 * (1.0 / 6227020800.0)))))));
    const double cp = 1.0 + r2 * (-0.5 + r2 * (1.0 / 24 + r2 * (-1.0 / 720 + r2 * (1.0 / 40320 + r2 * (-1.0 / 3628800 + r2 * (1.0 / 479001600.0 + r2 * (-1.0 / 87178291200.0)))))));
    const int q = ((int)k) & 3;
    const double sv = (q == 0) ? sp : (q == 1) ? cp : (q == 2) ? -sp : -cp;
    const double cv = (q == 0) ? cp : (q == 1) ? -sp : (q == 2) ? -cp : sp;
    c = (float)cv; s = (float)sv;
}

DI void prologue(const Params& P, LAS unsigned char* lds) {
    const int tid = threadIdx.x, G = gridDim.x, bid = blockIdx.x, lane = tid & 63, wid = tid >> 6;
    unsigned char* ws = P.ws;
    { LAS float* tile = (LAS float*)lds;
      constexpr int NT1 = (DM / 64) * (2 * DFF / 64), NT2 = (DFF / 64) * (DM / 64), NT3 = (DM / 64) * (DIN / 64), NT4 = (512 / 64) * (DM / 64), NT5 = (DM / 64) * (DM / 64);
      constexpr int C1 = NT1, C2 = C1 + NT2, C3 = C2 + NT3, C4 = C3 + NT4, C5 = C4 + NT4, C6 = C5 + NT5, C7 = C6 + NT1, C8 = C7 + NT2;
      const int ty = tid >> 4, tx = tid & 15, sn = tid >> 3, skp = tid & 7;
      const float* s0; const float* gp; bf16_t* dp; int sN;
      f32x4 v0 = {0.f, 0.f, 0.f, 0.f}, v1 = v0; float g0 = 1.f, g1 = 1.f;
#define TR_ADDR(t_, s0_, gp_, dp_, sN_) do { const int _l = (t_) / C8, _r = (t_) % C8; unsigned char* _wl = ws + WS_W + (size_t)_l * WL_B; \
        const float* _src; bf16_t* _dst; const float* _g = nullptr; int _K, _N, _perm = 0, _loc; \
        if (_r < C1) { _src = P.in[7] + (size_t)_l * DM * 2 * DFF; _dst = (bf16_t*)(_wl + WO1); _g = P.in[6] + _l * DM; _K = DM; _N = 2 * DFF; _perm = 1; _loc = _r; } \
        else if (_r < C2) { _src = P.in[8] + (size_t)_l * DFF * DM; _dst = (bf16_t*)(_wl + WO2); _K = DFF; _N = DM; _loc = _r - C1; } \
        else if (_r < C3) { _src = P.in[10] + (size_t)_l * DM * DIN; _dst = (bf16_t*)(_wl + WO3); _g = P.in[9] + _l * DM; _K = DM; _N = DIN; _loc = _r - C2; } \
        else if (_r < C4) { _src = P.in[14] + (size_t)_l * 512 * DM; _dst = (bf16_t*)(_wl + WO4); _K = 512; _N = DM; _loc = _r - C3; } \
        else if (_r < C5) { _src = P.in[15] + (size_t)_l * 512 * DM; _dst = (bf16_t*)(_wl + WO4) + (size_t)1024 * 512; _K = 512; _N = DM; _loc = _r - C4; } \
        else if (_r < C6) { _src = P.in[16] + (size_t)_l * DM * DM; _dst = (bf16_t*)(_wl + WO5); _K = DM; _N = DM; _loc = _r - C5; } \
        else if (_r < C7) { _src = P.in[18] + (size_t)_l * DM * 2 * DFF; _dst = (bf16_t*)(_wl + WO6); _g = P.in[17] + _l * DM; _K = DM; _N = 2 * DFF; _perm = 1; _loc = _r - C6; } \
        else { _src = P.in[19] + (size_t)_l * DFF * DM; _dst = (bf16_t*)(_wl + WO7); _K = DFF; _N = DM; _loc = _r - C7; } \
        const int _nk = _K / 64, _tn = _loc / _nk, _tk = _loc % _nk, _nb = _tn * 64; \
        const int _scol = _perm ? (((_nb & 255) < 128) ? (_nb >> 8) * 128 + (_nb & 255) : DFF + (_nb >> 8) * 128 + (_nb & 255) - 128) : _nb; \
        s0_ = _src + (size_t)(_tk * 64 + ty) * _N + _scol + 4 * tx; gp_ = _g ? _g + _tk * 64 + ty : nullptr; sN_ = _N; \
        dp_ = _dst + (size_t)(_nb + sn) * _K + _tk * 64 + 8 * skp; } while (0)
#define TR_BAR() do { asm volatile("s_waitcnt lgkmcnt(0)" ::: "memory"); __builtin_amdgcn_s_barrier(); asm volatile("" ::: "memory"); } while (0)
      int t = bid;
      if (t < NL * C8) { TR_ADDR(t, s0, gp, dp, sN); v0 = *(const f32x4*)s0; v1 = *(const f32x4*)(s0 + (size_t)32 * sN); if (gp) { g0 = gp[0]; g1 = gp[32]; } }
      while (t < NL * C8) {
          const f32x4 a = v0 * g0, b = v1 * g1;
          bf16_t* const dcur = dp;
          const int tn_ = t + G; g0 = 1.f; g1 = 1.f;
          if (tn_ < NL * C8) { TR_ADDR(tn_, s0, gp, dp, sN); v0 = *(const f32x4*)s0; v1 = *(const f32x4*)(s0 + (size_t)32 * sN); if (gp) { g0 = gp[0]; g1 = gp[32]; } }
          tile[ty * 65 + 4 * tx] = a[0]; tile[ty * 65 + 4 * tx + 1] = a[1]; tile[ty * 65 + 4 * tx + 2] = a[2]; tile[ty * 65 + 4 * tx + 3] = a[3];
          tile[(ty + 32) * 65 + 4 * tx] = b[0]; tile[(ty + 32) * 65 + 4 * tx + 1] = b[1]; tile[(ty + 32) * 65 + 4 * tx + 2] = b[2]; tile[(ty + 32) * 65 + 4 * tx + 3] = b[3];
          TR_BAR();
          { float e[8];
#pragma unroll
            for (int j = 0; j < 8; ++j) e[j] = tile[(8 * skp + j) * 65 + sn];
            u32x4 w; w.x = pk2(e[0], e[1]); w.y = pk2(e[2], e[3]); w.z = pk2(e[4], e[5]); w.w = pk2(e[6], e[7]);
            *(u32x4*)dcur = w; }
          TR_BAR();
          t = tn_;
      }
      asm volatile("s_waitcnt vmcnt(0)" ::: "memory");
      __syncthreads();
#undef TR_ADDR
#undef TR_BAR
    }
    { bf16_t* XB = (bf16_t*)(ws + WS_XB); float* SS = (float*)(ws + WS_SS);
      int row = bid * 8 + wid; f32x4 v[4];
#define XROW(r_) ((r_) < TP ? P.in[0] + (size_t)(r_) * DM : P.in[1] + (size_t)((r_) - TP) * DM)
      if (row < T) { const float* xr = XROW(row);
#pragma unroll
          for (int i = 0; i < 4; ++i) v[i] = *(const f32x4*)(xr + i * 256 + lane * 4); }
      while (row < T) {
          const int nrow = row + G * 8; f32x4 nv[4];
          if (nrow < T) { const float* xr = XROW(nrow);
#pragma unroll
              for (int i = 0; i < 4; ++i) nv[i] = *(const f32x4*)(xr + i * 256 + lane * 4); }
          else {
#pragma unroll
              for (int i = 0; i < 4; ++i) nv[i] = v[i]; }
          float ss = 0.f;
#pragma unroll
          for (int i = 0; i < 4; ++i) { ss += (v[i][0] * v[i][0] + v[i][1] * v[i][1]) + (v[i][2] * v[i][2] + v[i][3] * v[i][3]);
              u32x2 w; w.x = pk2(v[i][0], v[i][1]); w.y = pk2(v[i][2], v[i][3]); *(u32x2*)(XB + (size_t)row * DM + i * 256 + lane * 4) = w; }
#pragma unroll
          for (int o = 32; o >= 1; o >>= 1) ss += __shfl_xor(ss, o);
          if (lane < 16) SS[(size_t)row * 16 + lane] = lane == 0 ? ss : 0.f;
          row = nrow;
#pragma unroll
          for (int i = 0; i < 4; ++i) v[i] = nv[i];
      }
#undef XROW
    }
    { float* R = (float*)(ws + WS_ROPE);
      for (int e = bid * NTHR + tid; e < 8256 * 8; e += G * NTHR) {
          const int pi = e >> 3, i = e & 7; const int pos = pi < 8192 ? pi : 4096 + (pi - 8192);
          const double fr = (i == 0) ? 1.0 : (i == 1) ? 0.1939227432012558 : (i == 2) ? 0.03760603070259094 : (i == 3) ? 0.007292664609849453 : (i == 4) ? 0.0014142135623842478
                          : (i == 5) ? 0.00027424818836152554 : (i == 6) ? 5.3182957344688475e-05 : 1.0313385246263351e-05;
          const float angf = (float)pos * (float)fr;
          float c, s; sincos_d((double)angf, c, s);
          R[(size_t)pi * 16 + i] = c; R[(size_t)pi * 16 + 8 + i] = s;
      } }
}

DI void cache_copy_part(const Params& P, int part, int rank, int nranks) {
    int tid_ = threadIdx.x; asm volatile("" : "+v"(tid_));
    const size_t gt = (size_t)rank * NTHR + tid_, gs = (size_t)nranks * NTHR;
#define CP4(N_, PER_, SRCK_, SRCV_, DSTK_, DSTV_, BLK_, OFF_) do { const size_t _lo = (size_t)(N_) * part / 4, _hi = (size_t)(N_) * (part + 1) / 4; \
      for (size_t e0 = _lo + gt; e0 < _hi; e0 += 4 * gs) { f32x4 kv[4], vv[4]; \
          _Pragma("unroll") for (int q = 0; q < 4; ++q) { const size_t e = e0 + q * gs; if (e < _hi) { const size_t blk = e / (PER_), r = e % (PER_); \
              kv[q] = *(const f32x4*)((SRCK_) + blk * (BLK_) + (OFF_) + r * 4); vv[q] = *(const f32x4*)((SRCV_) + blk * (BLK_) + (OFF_) + r * 4); } } \
          _Pragma("unroll") for (int q = 0; q < 4; ++q) { const size_t e = e0 + q * gs; if (e < _hi) { const size_t blk = e / (PER_), r = e % (PER_); \
              *(f32x4*)((DSTK_) + blk * (BLK_) + r * 4) = kv[q]; *(f32x4*)((DSTV_) + blk * (BLK_) + r * 4) = vv[q]; } } } } while (0)
    CP4((size_t)2 * 32 * 2048, (size_t)2048, P.in[2], P.in[3], P.out + O_KWS, P.out + O_VWS, (size_t)16384, (size_t)8192);
    CP4((size_t)2 * 32 * 57344, (size_t)57344, P.in[4], P.in[5], P.out + O_KBS, P.out + O_VBS, (size_t)262144, (size_t)32768);
#undef CP4
}

constexpr int AT_KS = 0, AT_VT = 2 * 9216, AT_BT = 4 * 9216;
struct TileSrc { const unsigned char* k; const unsigned char* v; int f32; int ldb; };

DI void attn_phase(const Params& P, LAS unsigned char* lds, int layer) {
    int tid_ = threadIdx.x; asm volatile("" : "+v"(tid_));
    const int tid = tid_, lane = tid & 63, wid = __builtin_amdgcn_readfirstlane(tid >> 6), G = gridDim.x;
    unsigned char* ws = P.ws;
    const bf16_t* QA = (const bf16_t*)(ws + WS_REG + REG_QA); const bf16_t* QB = (const bf16_t*)(ws + WS_REG + REG_QB);
    const bf16_t* KA = (const bf16_t*)(ws + WS_KA); const bf16_t* VA = (const bf16_t*)(ws + WS_VA);
    const bf16_t* KBp = (const bf16_t*)(ws + WS_KB); const bf16_t* VBp = (const bf16_t*)(ws + WS_VB);
    bf16_t* YA = (bf16_t*)(ws + WS_XB); bf16_t* YB = YA + (size_t)T * 512;
    const float* ckw = P.in[2] + (size_t)layer * 32 * 128 * 128; const float* cvw = P.in[3] + (size_t)layer * 32 * 128 * 128;
    const float* ckb = P.in[4] + (size_t)layer * 32 * 512 * 512; const float* cvb = P.in[5] + (size_t)layer * 32 * 512 * 512;
    const float* sinks = P.in[12] + layer * 8; const float* relb = P.in[13] + (size_t)layer * 8 * 257;
    LAS float* bt = (LAS float*)(lds + AT_BT);
    const int key = tid >> 3, dp = tid & 7;
    const int ql = lane & 31, h = lane >> 5;

    for (int it = 0; it < 10; ++it) {
        const int c = blockIdx.x;
        int mixB, smp, b = 0, hk, c0 = 0, j0, j1, ncache = 0;
        if (it < 4) { const int bh = it * 8 + (c & 7); mixB = 1; smp = 0; b = bh >> 3; hk = bh & 7; c0 = 4 * (c >> 3); j0 = c0 - 8 < 0 ? 0 : c0 - 8; j1 = c0 + 3; }
        else if (it == 4) { mixB = 1; smp = 1; b = c >> 3; hk = c & 7; c0 = 8; j0 = 0; j1 = 8; ncache = 8; }
        else if (it < 9) { mixB = 0; smp = 0; b = it - 5; hk = c & 1; c0 = ((c & 7) >> 1) * 32 + (c >> 3); j0 = c0 - 2 < 0 ? 0 : c0 - 2; j1 = c0; }
        else { if (c >= 64) break; mixB = 0; smp = 1; b = c >> 1; hk = c & 1; c0 = 2; j0 = 0; j1 = 2; ncache = 2; }
        const int ldkv = mixB ? 512 : 128;
        const bf16_t* Kbuf = mixB ? KBp : KA; const bf16_t* Vbuf = mixB ? VBp : VA;
        const float* ck = mixB ? ckb : ckw; const float* cv = mixB ? cvb : cvw;
        const int clen = mixB ? 512 : 128, nh = mixB ? 8 : 2;
        int cw, hq, wlo, whi; long qrow0;
        if (!mixB) { cw = c0; hq = 4 * hk + (wid >> 1); wlo = j0; whi = j1; }
        else if (!smp) { cw = c0 + (wid >> 1); hq = hk; wlo = cw - 8 < 0 ? 0 : cw - 8; whi = cw; }
        else { cw = 8; hq = hk; wlo = wid < 2 ? 0 : 1; whi = wid < 2 ? 8 : 0; }
        qrow0 = (smp ? (long)TP + b * 64 : (long)b * 8192 + (long)cw * 64) + 32 * (wid & 1);
        const bool wave_on = wlo <= whi;
        const bf16_t* Qp = (mixB ? QB : QA) + (size_t)(qrow0 + ql) * 512 + hq * 64 + 8 * h;
        bf16x8 qf[4];
        if (wave_on) {
#pragma unroll
            for (int s = 0; s < 4; ++s) qf[s] = *(const bf16x8*)(Qp + 16 * s);
        } else {
#pragma unroll
            for (int s = 0; s < 4; ++s) qf[s] = (bf16x8){0, 0, 0, 0, 0, 0, 0, 0};
        }
        if (mixB) { for (int i = tid; i < 257; i += NTHR) bt[i] = relb[hk * 257 + i] * LOG2E; }
        const float sinkv = mixB ? -1e30f : sinks[hq] * LOG2E;
        float m_run = sinkv, l_run = 0.f;
        f32x16 O0, O1;
#pragma unroll
        for (int r = 0; r < 16; ++r) { O0[r] = 0.f; O1[r] = 0.f; }

        auto tsrc = [&](int j) -> TileSrc { TileSrc s;
            if (!smp) { const size_t row = (size_t)b * 8192 + (size_t)j * 64; s.k = (const unsigned char*)(Kbuf + row * ldkv + hk * 64); s.v = (const unsigned char*)(Vbuf + row * ldkv + hk * 64); s.f32 = 0; s.ldb = ldkv * 2; }
            else if (j < ncache) { const size_t e = (((size_t)b * clen + (size_t)j * 64) * nh + hk) * 64; s.k = (const unsigned char*)(ck + e); s.v = (const unsigned char*)(cv + e); s.f32 = 1; s.ldb = nh * 64 * 4; }
            else { const size_t row = (size_t)TP + (size_t)b * 64; s.k = (const unsigned char*)(Kbuf + row * ldkv + hk * 64); s.v = (const unsigned char*)(Vbuf + row * ldkv + hk * 64); s.f32 = 0; s.ldb = ldkv * 2; }
            return s; };
        u32x4 rg[4]; int rg_f32 = 0;
#define AT_LOAD(j, rg, rg_f32) do { const TileSrc _s = tsrc(j); rg_f32 = _s.f32; \
            if (_s.f32) { const unsigned char* kp = _s.k + (size_t)key * _s.ldb + dp * 32; const unsigned char* vp = _s.v + (size_t)key * _s.ldb + dp * 32; \
                rg[0] = *(const u32x4*)kp; rg[1] = *(const u32x4*)(kp + 16); rg[2] = *(const u32x4*)vp; rg[3] = *(const u32x4*)(vp + 16); } \
            else { rg[0] = *(const u32x4*)(_s.k + (size_t)key * _s.ldb + dp * 16); rg[2] = *(const u32x4*)(_s.v + (size_t)key * _s.ldb + dp * 16); \
                   rg[1] = (u32x4){0u, 0u, 0u, 0u}; rg[3] = (u32x4){0u, 0u, 0u, 0u}; } } while (0)
#define AT_WRITE(buf, rg, rg_f32) do { u32x4 kk, vv; \
            if (rg_f32) { kk.x = pk2(__uint_as_float(rg[0].x), __uint_as_float(rg[0].y)); kk.y = pk2(__uint_as_float(rg[0].z), __uint_as_float(rg[0].w)); \
                          kk.z = pk2(__uint_as_float(rg[1].x), __uint_as_float(rg[1].y)); kk.w = pk2(__uint_as_float(rg[1].z), __uint_as_float(rg[1].w)); \
                          vv.x = pk2(__uint_as_float(rg[2].x), __uint_as_float(rg[2].y)); vv.y = pk2(__uint_as_float(rg[2].z), __uint_as_float(rg[2].w)); \
                          vv.z = pk2(__uint_as_float(rg[3].x), __uint_as_float(rg[3].y)); vv.w = pk2(__uint_as_float(rg[3].z), __uint_as_float(rg[3].w)); } \
            else { kk = rg[0]; vv = rg[2]; } \
            *(LAS u32x4*)(lds + AT_KS + (buf) * 9216 + key * 144 + dp * 16) = kk; \
            LAS bf16_t* vt = (LAS bf16_t*)(lds + AT_VT + (buf) * 9216) + (8 * dp) * 72 + ((((key >> 2) ^ dp) << 2) | (key & 3)); \
            vt[0 * 72] = (bf16_t)(vv.x & 0xffffu); vt[1 * 72] = (bf16_t)(vv.x >> 16); vt[2 * 72] = (bf16_t)(vv.y & 0xffffu); vt[3 * 72] = (bf16_t)(vv.y >> 16); \
            vt[4 * 72] = (bf16_t)(vv.z & 0xffffu); vt[5 * 72] = (bf16_t)(vv.z >> 16); vt[6 * 72] = (bf16_t)(vv.w & 0xffffu); vt[7 * 72] = (bf16_t)(vv.w >> 16); } while (0)

        AT_LOAD(j0, rg, rg_f32); AT_WRITE(0, rg, rg_f32);
        __builtin_amdgcn_s_waitcnt(0);
#pragma unroll
        for (int s = 0; s < 4; ++s) asm volatile("" : "+v"(qf[s]));
        if (j0 < j1) AT_LOAD(j0 + 1, rg, rg_f32);
        asm volatile("s_waitcnt lgkmcnt(0)" ::: "memory"); __builtin_amdgcn_s_barrier(); asm volatile("" ::: "memory");
        for (int j = j0; j <= j1; ++j) {
            const int buf = (j - j0) & 1;
            if (wave_on && j >= wlo && j <= whi) {
                const LAS unsigned char* Ks = lds + AT_KS + buf * 9216; const LAS unsigned char* Vt = lds + AT_VT + buf * 9216;
                f32x16 S0, S1; bf16x8 kf0[4], kf1[4];
#pragma unroll
                for (int r = 0; r < 16; ++r) { S0[r] = 0.f; S1[r] = 0.f; }
#pragma unroll
                for (int s = 0; s < 4; ++s) { kf0[s] = *(const LAS bf16x8*)(Ks + ql * 144 + 32 * s + 16 * h); kf1[s] = *(const LAS bf16x8*)(Ks + (32 + ql) * 144 + 32 * s + 16 * h); }
                __builtin_amdgcn_sched_barrier(0);
                __builtin_amdgcn_s_setprio(1);
#pragma unroll
                for (int s = 0; s < 4; ++s) {
                    S0 = __builtin_amdgcn_mfma_f32_32x32x16_bf16(kf0[s], qf[s], S0, 0, 0, 0);
                    S1 = __builtin_amdgcn_mfma_f32_32x32x16_bf16(kf1[s], qf[s], S1, 0, 0, 0);
                }
                __builtin_amdgcn_s_setprio(0);
                bf16x8 vf0[4], vf1[4];
#pragma unroll
                for (int kb = 0; kb < 2; ++kb)
#pragma unroll
                    for (int s = 0; s < 2; ++s) {
                        const int kg = 8 * kb + 4 * s + h;
                        const int ko = (kg ^ (ql >> 3)) << 3, ko2 = ((kg + 2) ^ (ql >> 3)) << 3;
                        { const s16x4 lo = *(const LAS s16x4*)(Vt + ql * 144 + ko), hi = *(const LAS s16x4*)(Vt + ql * 144 + ko2);
                          vf0[kb * 2 + s] = __builtin_shufflevector(lo, hi, 0, 1, 2, 3, 4, 5, 6, 7); }
                        { const s16x4 lo = *(const LAS s16x4*)(Vt + (32 + ql) * 144 + (ko ^ 32)), hi = *(const LAS s16x4*)(Vt + (32 + ql) * 144 + (ko2 ^ 32));
                          vf1[kb * 2 + s] = __builtin_shufflevector(lo, hi, 0, 1, 2, 3, 4, 5, 6, 7); }
                    }
                __builtin_amdgcn_sched_barrier(0);
                if (mixB) {
                    const int rel0 = 64 * (j - cw);
                    if (rel0 <= -192) { const float bb = bt[0];
#pragma unroll
                        for (int r = 0; r < 16; ++r) { S0[r] += bb; S1[r] += bb; }
                    } else if (rel0 >= -64) {
                        const LAS float* bp = bt + (rel0 - (32 * (wid & 1) + ql) + 4 * h + 128);
#pragma unroll
                        for (int r = 0; r < 16; ++r) { const int kk = (r & 3) + 8 * (r >> 2); S0[r] += bp[kk]; S1[r] += bp[32 + kk]; }
                    } else {
                        const int base = rel0 - (32 * (wid & 1) + ql) + 4 * h + 128;
#pragma unroll
                        for (int r = 0; r < 16; ++r) { const int kk = (r & 3) + 8 * (r >> 2);
                            int i0 = base + kk, i1 = base + 32 + kk; i0 = i0 < 0 ? 0 : (i0 > 256 ? 256 : i0); i1 = i1 < 0 ? 0 : (i1 > 256 ? 256 : i1);
                            S0[r] += bt[i0]; S1[r] += bt[i1]; }
                    }
                }
                float mx = S0[0];
#pragma unroll
                for (int r = 1; r < 16; ++r) mx = fmaxf(mx, S0[r]);
#pragma unroll
                for (int r = 0; r < 16; ++r) mx = fmaxf(mx, S1[r]);
                mx = fmaxf(mx, __shfl_xor(mx, 32));
                const float mn = fmaxf(m_run, mx); const float alpha = fast_exp2(m_run - mn); m_run = mn;
                float ps = 0.f;
#pragma unroll
                for (int r = 0; r < 16; ++r) { S0[r] = fast_exp2(S0[r] - mn); S1[r] = fast_exp2(S1[r] - mn); ps += S0[r] + S1[r]; }
                l_run = l_run * alpha + ps;
#pragma unroll
                for (int r = 0; r < 16; ++r) { O0[r] *= alpha; O1[r] *= alpha; }
#pragma unroll
                for (int kb = 0; kb < 2; ++kb)
#pragma unroll
                    for (int s = 0; s < 2; ++s) {
                        u32x4 pw;
#pragma unroll
                        for (int q = 0; q < 4; ++q) pw[q] = kb == 0 ? pk2(S0[8 * s + 2 * q], S0[8 * s + 2 * q + 1]) : pk2(S1[8 * s + 2 * q], S1[8 * s + 2 * q + 1]);
                        const bf16x8 pf = __builtin_bit_cast(bf16x8, pw);
                        __builtin_amdgcn_s_setprio(1);
                        O0 = __builtin_amdgcn_mfma_f32_32x32x16_bf16(vf0[kb * 2 + s], pf, O0, 0, 0, 0);
                        O1 = __builtin_amdgcn_mfma_f32_32x32x16_bf16(vf1[kb * 2 + s], pf, O1, 0, 0, 0);
                        __builtin_amdgcn_s_setprio(0);
                    }
            }
            if (j < j1) { AT_WRITE(buf ^ 1, rg, rg_f32); if (j + 2 <= j1) AT_LOAD(j + 2, rg, rg_f32); }
            asm volatile("s_waitcnt lgkmcnt(0)" ::: "memory"); __builtin_amdgcn_s_barrier(); asm volatile("" ::: "memory");
        }
#undef AT_LOAD
#undef AT_WRITE
        if (wave_on) {
            float lt = l_run + __shfl_xor(l_run, 32);
            if (!mixB) lt += fast_exp2(sinkv - m_run);
            const float inv = 1.0f / lt;
            bf16_t* yp = (mixB ? YB : YA) + (size_t)(qrow0 + ql) * 512 + hq * 64 + 4 * h;
#pragma unroll
            for (int g4 = 0; g4 < 4; ++g4) {
                u32x2 w0, w1;
                w0.x = pk2(O0[4 * g4] * inv, O0[4 * g4 + 1] * inv); w0.y = pk2(O0[4 * g4 + 2] * inv, O0[4 * g4 + 3] * inv);
                w1.x = pk2(O1[4 * g4] * inv, O1[4 * g4 + 1] * inv); w1.y = pk2(O1[4 * g4 + 2] * inv, O1[4 * g4 + 3] * inv);
                *(u32x2*)(yp + 8 * g4) = w0; *(u32x2*)(yp + 32 + 8 * g4) = w1;
            }
        }
    }
}

DI void final_phase(const Params& P) {
    const int tid = threadIdx.x, lane = tid & 63, wid = tid >> 6, G = gridDim.x;
    const float* SS = (const float*)(P.ws + WS_SS); const float* g = P.in[20];
    f32x4 gv[4];
#pragma unroll
    for (int i = 0; i < 4; ++i) gv[i] = *(const f32x4*)(g + i * 256 + lane * 4);
    int row = blockIdx.x * 8 + wid; f32x4 v[4]; f32x4 sv = {0.f, 0.f, 0.f, 0.f};
    if (row < T) { const float* xr = P.out + O_Y + (size_t)row * DM; sv = *(const f32x4*)(SS + (size_t)row * 16 + 4 * (lane & 3));
#pragma unroll
        for (int i = 0; i < 4; ++i) v[i] = *(const f32x4*)(xr + i * 256 + lane * 4); }
    while (row < T) {
        const int nrow = row + G * 8; f32x4 nv[4]; f32x4 nsv = sv;
        if (nrow < T) { const float* xr = P.out + O_Y + (size_t)nrow * DM; nsv = *(const f32x4*)(SS + (size_t)nrow * 16 + 4 * (lane & 3));
#pragma unroll
            for (int i = 0; i < 4; ++i) nv[i] = *(const f32x4*)(xr + i * 256 + lane * 4); }
        else {
#pragma unroll
            for (int i = 0; i < 4; ++i) nv[i] = v[i]; }
        float t = (sv[0] + sv[1]) + (sv[2] + sv[3]); t += __shfl_xor(t, 1); t += __shfl_xor(t, 2);
        const float rs = rsqrtf(t * (1.0f / 1024.0f) + EPS);
        float* xo = P.out + O_Y + (size_t)row * DM;
#pragma unroll
        for (int i = 0; i < 4; ++i) *(f32x4*)(xo + i * 256 + lane * 4) = v[i] * rs * gv[i];
        row = nrow; sv = nsv;
#pragma unroll
        for (int i = 0; i < 4; ++i) v[i] = nv[i];
    }
}

#define XB_TMO      128
#define XB_XCNT(j)  (256  + 64 * (j))
#define XB_XSUB(j)  (1280 + 64 * (j))
#define XB_XGEN(j)  (2304 + 64 * (j))
#define XB_TOP      3328
#define XB_TOPGEN   3392
#define XCD_BAR_WORDS 3456
#define XB_SPIN_CAP (1u << 22)
DI unsigned xb_ld(unsigned* p) { return __hip_atomic_load(p, __ATOMIC_RELAXED, __HIP_MEMORY_SCOPE_AGENT); }
DI unsigned xb_add(unsigned* p, unsigned v) { return __hip_atomic_fetch_add(p, v, __ATOMIC_RELAXED, __HIP_MEMORY_SCOPE_AGENT); }
DI unsigned xb_xcc_id() { return (unsigned)__builtin_amdgcn_s_getreg((3 << 11) | 20) & 0xFu; }
#define XB_SPIN(cond, bar) do { unsigned _sp = 0; while (cond) { __builtin_amdgcn_s_sleep(1); \
    if ((++_sp & 255u) == 0u) { if (xb_ld(&(bar)[XB_TMO])) break; if (_sp > XB_SPIN_CAP) { atomicAdd(&(bar)[XB_TMO], 1u); break; } } } } while (0)
struct XcdBarrier { unsigned* bar; unsigned x; volatile LAS unsigned* st; };
DI XcdBarrier xcd_barrier_post(unsigned* bar, volatile LAS unsigned* st) {
    XcdBarrier b; b.bar = bar; b.x = xb_xcc_id(); b.st = st;
    if (threadIdx.x == 0) (void)xb_add(&bar[XB_XCNT(b.x)], 1u);
    return b;
}
DI void xcd_barrier_complete(unsigned* bar, unsigned x, unsigned& nloc, unsigned& nx) {
    const unsigned G = gridDim.x;
    unsigned sum, cnt, mine, sp = 0u;
    for (;;) {
        sum = 0u; cnt = 0u; mine = 0u;
#pragma unroll
        for (unsigned j = 0; j < 16; ++j) { const unsigned c = xb_ld(&bar[XB_XCNT(j)]); sum += c; cnt += (c > 0u) ? 1u : 0u; mine = (j == x) ? c : mine; }
        if (sum == G) break;
        __builtin_amdgcn_s_sleep(1);
        if ((++sp & 255u) == 0u) { if (xb_ld(&bar[XB_TMO])) break; if (sp > XB_SPIN_CAP) { atomicAdd(&bar[XB_TMO], 1u); break; } }
    }
    nloc = mine > 0u ? mine : 1u; nx = cnt > 0u ? cnt : 1u;
}
DI void xcd_barrier(const XcdBarrier& b) {
    asm volatile("s_waitcnt vmcnt(0)" ::: "memory");
    __syncthreads();
    if (threadIdx.x == 0) {
        unsigned* bar = b.bar;
        __builtin_amdgcn_s_waitcnt(0);
        unsigned nloc = b.st[0], nx = b.st[1];
        if (nloc == 0u) { xcd_barrier_complete(bar, b.x, nloc, nx); b.st[0] = nloc; b.st[1] = nx; }
        const unsigned old = xb_add(&bar[XB_XSUB(b.x)], 1u);
        const unsigned gen = old / nloc;
        if (old + 1u == (gen + 1u) * nloc) {
            __builtin_amdgcn_fence(__ATOMIC_RELEASE, "agent");
            asm volatile("s_waitcnt vmcnt(0)" ::: "memory");
            const unsigned og = xb_add(&bar[XB_TOP], 1u);
            const unsigned tg = og / nx;
            if (og + 1u == (tg + 1u) * nx) xb_add(&bar[XB_TOPGEN], 1u);
            else XB_SPIN(xb_ld(&bar[XB_TOPGEN]) == tg, bar);
            __builtin_amdgcn_fence(__ATOMIC_ACQUIRE, "agent");
            xb_add(&bar[XB_XGEN(b.x)], 1u);
            asm volatile("s_waitcnt vmcnt(0)" ::: "memory");
        } else {
            XB_SPIN(xb_ld(&bar[XB_XGEN(b.x)]) == gen, bar);
            __builtin_amdgcn_fence(__ATOMIC_ACQUIRE, "agent");
            asm volatile("s_waitcnt vmcnt(0)" ::: "memory");
        }
    }
    __syncthreads();
}

__global__ void __launch_bounds__(NTHR) fwd_megakernel(Params P, int ph_lo, int ph_hi) {
    extern __shared__ __attribute__((aligned(16))) unsigned char lds_raw[];
    LAS unsigned char* lds = (LAS unsigned char*)lds_raw;
    cg::grid_group grid = cg::this_grid();
    unsigned char* ws = P.ws; const int G = gridDim.x, bid = blockIdx.x;
    bf16_t* XB = (bf16_t*)(ws + WS_XB); float* SS = (float*)(ws + WS_SS); float* X = P.out + O_Y;
    bf16_t* HID = (bf16_t*)(ws + WS_REG); bf16_t* MB = (bf16_t*)(ws + WS_REG + REG_MB); bf16_t* GATES = (bf16_t*)(ws + WS_REG + REG_GATES);
    volatile LAS unsigned* xst = (volatile LAS unsigned*)(lds + pg8::STAGE_BYTES);
    if (threadIdx.x < 4) xst[threadIdx.x] = 0u;
    __syncthreads();
    if (blockIdx.x == 0) { unsigned* bw = (unsigned*)(ws + WS_BAR); for (int i = threadIdx.x; i < XCD_BAR_WORDS; i += NTHR) __hip_atomic_store(bw + i, 0u, __ATOMIC_RELAXED, __HIP_MEMORY_SCOPE_AGENT); }
    XcdBarrier xbar; xbar.bar = (unsigned*)(ws + WS_BAR); xbar.x = 0; xbar.st = xst;
    float* SLAB = (float*)(ws + WS_SLAB); unsigned* CNT = (unsigned*)(ws + WS_CNT);
    int ph = 0;
#define SEAM() do { ++ph; if (ph > ph_lo && ph < ph_hi) { if (ph == 1) grid.sync(); else xcd_barrier(xbar); } } while (0)
#define RUN (ph >= ph_lo && ph < ph_hi)
    if (RUN) prologue(P, lds);
    SEAM();
    xbar = xcd_barrier_post((unsigned*)(ws + WS_BAR), xst);
    for (int l = 0; l < NL; ++l) {
        const unsigned char* wl = ws + WS_W + (size_t)l * WL_B;
        for (int f = 0; f < 2; ++f) {
            if (f == 1) {
                if (RUN) { pg8::Gemm g{XB, (const bf16_t*)(wl + WO3), T, DIN, DM}; pg8::StaticOrder<T, DIN, DM, false, 1> S; S.init(bid, SLAB, CNT + ph * 256);
                    EpiProj E{ws, P.in[11] + l * 2048, P.out, l};
                    pg8::gemm_phase(lds, g, S, E); }
                SEAM();
                if (RUN) {
                    if (bid < 8) { pg8::Gemm g{XB, (const bf16_t*)(wl + WO3), T, DIN, DM}; pg8::StaticOrder<T, DIN, DM, false, 2> S; S.init(bid, SLAB, CNT + ph * 256);
                        EpiProj E{ws, P.in[11] + l * 2048, P.out, l};
                        pg8::gemm_phase(lds, g, S, E); }
                    attn_phase(P, lds, l); }
                SEAM();
                if (RUN) { pg8::Gemm g{XB  , (const bf16_t*)(wl + WO4), 2 * T, 2048, 512}; pg8::MergeOrder S; S.so.init(bid, nullptr, nullptr); S.slab = nullptr; S.cnt = nullptr;
                    EpiMerge E{GATES, MB}; pg8::gemm_phase(lds, g, S, E); }
                if (RUN) small_merge(lds, XB + (size_t)TP * 512, XB + (size_t)T * 512 + (size_t)TP * 512, (const bf16_t*)(wl + WO4), GATES + (size_t)TP * 2048, MB + (size_t)TP * DM);
                SEAM();
                if (RUN) { pg8::Gemm g{MB, (const bf16_t*)(wl + WO5), T, DM, DM}; pg8::StaticOrder<TP, DM, DM, false> S; S.init(bid, SLAB, CNT + ph * 256);
                    EpiResid E{X, X + (size_t)TP * DM, X, XB, SS, 1.0f, true}; pg8::gemm_phase(lds, g, S, E); }
                if (RUN) small_resid(lds, MB + (size_t)TP * DM, (const bf16_t*)(wl + WO5), DM, X + (size_t)TP * DM, X + (size_t)TP * DM, XB + (size_t)TP * DM, SS + (size_t)TP * 16, 1.0f);
                SEAM();
            }
            if (RUN) { pg8::Gemm g{XB, (const bf16_t*)(wl + (f ? WO6 : WO1)), T, 2 * DFF, DM}; pg8::StaticOrder<T, 2 * DFF, DM, true> S; S.init(bid, SLAB, CNT + ph * 256);
                EpiSwiglu E{HID, SS}; pg8::gemm_phase(lds, g, S, E);
                if (bid >= 176) cache_copy_part(P, 2 * l + f, bid - 176, 80); }
            SEAM();
            if (RUN) { pg8::Gemm g{HID, (const bf16_t*)(wl + (f ? WO7 : WO2)), T, DM, DFF}; pg8::StaticOrder<TP, DM, DFF, false> S; S.init(bid, SLAB, CNT + ph * 256);
                const bool first = (l == 0 && f == 0);
                const bool wxb = !(l == NL - 1 && f == 1);
                EpiResid E{first ? P.in[0] : X, first ? P.in[1] : X + (size_t)TP * DM, X, XB, SS, 0.5f, wxb}; pg8::gemm_phase(lds, g, S, E);
                small_resid(lds, HID + (size_t)TP * DFF, (const bf16_t*)(wl + (f ? WO7 : WO2)), DFF, first ? P.in[1] : X + (size_t)TP * DM, X + (size_t)TP * DM, XB + (size_t)TP * DM, SS + (size_t)TP * 16, 0.5f, wxb); }
            SEAM();
        }
    }
    if (RUN) final_phase(P);
#undef SEAM
#undef RUN
}

constexpr int LDS_BYTES = BG_OFF + 8192;
constexpr int N_PHASES = 1 + NL * 8 + 1;
constexpr int GRID_HOST = pg8::GRID;

extern "C" void kernel_launch(void* const* d_in, const int* in_sizes, int n_in, void* d_out, int out_size, void* d_ws, size_t ws_size, hipStream_t stream) {
    static int grid = 0;
    if (grid == 0) {
        if (n_in != 21 || (size_t)out_size != O_END || ws_size < WS_END) { fprintf(stderr, "kernel_launch: unexpected shapes: n_in %d out %d ws %zu (need %zu)\n", n_in, out_size, ws_size, (size_t)WS_END); grid = -1; return; }
        int dev = 0, cus = 0, per_cu = 0;
        hipGetDevice(&dev); hipDeviceGetAttribute(&cus, hipDeviceAttributeMultiprocessorCount, dev);
        if (hipFuncSetAttribute((const void*)fwd_megakernel, hipFuncAttributeMaxDynamicSharedMemorySize, LDS_BYTES) != hipSuccess) { fprintf(stderr, "kernel_launch: hipFuncSetAttribute failed\n"); grid = -1; return; }
        if (hipOccupancyMaxActiveBlocksPerMultiprocessor(&per_cu, (const void*)fwd_megakernel, NTHR, LDS_BYTES) != hipSuccess || per_cu < 1) per_cu = 1;
        (void)hipGetLastError();
        if (cus * per_cu < GRID_HOST) fprintf(stderr, "kernel_launch: device admits %d workgroups, kernel needs %d\n", cus * per_cu, GRID_HOST);
        grid = GRID_HOST;
        fprintf(stderr, "kernel_launch: grid %d (cus %d x %d)\n", grid, cus, per_cu);
    }
    if (grid < 0) return;
    Params p{};
    for (int i = 0; i < 21; ++i) p.in[i] = (const float*)d_in[i];
    p.out = (float*)d_out; p.ws = (unsigned char*)d_ws;
    int lo = 0, hi = N_PHASES;
    void* args[] = {&p, &lo, &hi};
    hipError_t e = hipLaunchCooperativeKernel((const void*)fwd_megakernel, dim3(grid), dim3(NTHR), args, LDS_BYTES, stream);
    if (e != hipSuccess) fprintf(stderr, "kernel_launch: cooperative launch failed: %s (grid %d)\n", hipGetErrorString(e), grid);
}
```
